# Optimizing an MI355X kernel written in HIP

```python
import jax, jax.numpy as jnp
from jax import lax
import numpy as np

D_MODEL = 1024
BATCH = 4
SEQ = 8192
DEPTH = 2

GRID_W = 64
CTX_LEN = 256
MLA_HEADS = 8
MLA_NOPE = 64
MLA_ROPE = 32
MLA_V = 64
MLA_QK = MLA_NOPE + MLA_ROPE
MLA_WIDTH = MLA_HEADS * MLA_V
Q_RANK = 256
KV_RANK = 128
SC_WIDTH = 256
SC_K = 3
CF_WIDTH = 256
CF_K = 31
D_MIX = MLA_WIDTH + SC_WIDTH + CF_WIDTH
IN_SPLITS = (Q_RANK, KV_RANK, MLA_ROPE, MLA_WIDTH, SC_WIDTH, SC_WIDTH, SC_WIDTH, SC_WIDTH, 2 * CF_WIDTH, CF_WIDTH)
D_IN = Q_RANK + KV_RANK + MLA_ROPE + MLA_WIDTH + 4 * SC_WIDTH + 3 * CF_WIDTH
ROPE_THETA = 10000.0
Q_BLOCK = 128
EPS = 1e-6
LN_EPS = 1e-5

kernel_name = 'hybrid_mla_shortconv_conformer_dit'


def rms_norm(x, w):
    xf = x.astype(jnp.float32)
    y = xf * lax.rsqrt(jnp.mean(xf * xf, axis=-1, keepdims=True) + EPS)
    return (y * w.astype(jnp.float32)).astype(x.dtype)


def layer_norm(x, w, b):
    xf = x.astype(jnp.float32)
    mu = jnp.mean(xf, axis=-1, keepdims=True)
    var = jnp.mean(jnp.square(xf - mu), axis=-1, keepdims=True)
    y = (xf - mu) * lax.rsqrt(var + LN_EPS)
    return (y * w.astype(jnp.float32) + b.astype(jnp.float32)).astype(x.dtype)


def axial_rope_tables(T):
    rows = T // GRID_W
    pos_r = jnp.repeat(jnp.arange(rows, dtype=jnp.float32), GRID_W)
    pos_c = jnp.tile(jnp.arange(GRID_W, dtype=jnp.float32), rows)
    n_freq = MLA_ROPE // 4
    inv = ROPE_THETA ** (-jnp.arange(n_freq, dtype=jnp.float32) / n_freq)
    ang = jnp.concatenate([pos_r[:, None] * inv, pos_c[:, None] * inv], axis=-1)
    return jnp.cos(ang), jnp.sin(ang)


def apply_rope(x, cos, sin):
    half = x.shape[-1] // 2
    x1, x2 = x[..., :half], x[..., half:]
    cs = cos[None, :, None, :].astype(x.dtype)
    sn = sin[None, :, None, :].astype(x.dtype)
    return jnp.concatenate([x1 * cs - x2 * sn, x2 * cs + x1 * sn], axis=-1)


def dwconv(x, w):
    return lax.conv_general_dilated(x, w[:, None, :], window_strides=(1,), padding='SAME',
                                    dimension_numbers=('NWC', 'WIO', 'NWC'),
                                    feature_group_count=x.shape[-1])


def split_in(u):
    offsets = np.cumsum(IN_SPLITS)[:-1].tolist()
    return jnp.split(u, offsets, axis=-1)


def mla_q(cq, q_norm_w, w_uq, q_head_norm_w, cos, sin):
    B, T, _ = cq.shape
    q = (rms_norm(cq, q_norm_w) @ w_uq).reshape(B, T, MLA_HEADS, MLA_QK)
    q = rms_norm(q, q_head_norm_w)
    if cos is not None:
        q = jnp.concatenate([q[..., :MLA_NOPE], apply_rope(q[..., MLA_NOPE:], cos, sin)], axis=-1)
    return q


def mla_kv(ckv, kr, kv_norm_w, w_ukv, k_head_norm_w, cos, sin):
    B, T, _ = ckv.shape
    kv = (rms_norm(ckv, kv_norm_w) @ w_ukv).reshape(B, T, MLA_HEADS, MLA_NOPE + MLA_V)
    k_nope, v = kv[..., :MLA_NOPE], kv[..., MLA_NOPE:]
    k_rope = jnp.broadcast_to(kr[:, :, None, :], (B, T, MLA_HEADS, MLA_ROPE))
    k = rms_norm(jnp.concatenate([k_nope, k_rope], axis=-1), k_head_norm_w)
    if cos is not None:
        k = jnp.concatenate([k[..., :MLA_NOPE], apply_rope(k[..., MLA_NOPE:], cos, sin)], axis=-1)
    return k, v


def attend(q, k, v):
    B, T, H, Dq = q.shape
    nb = T // Q_BLOCK
    qb = q.reshape(B, nb, Q_BLOCK, H, Dq).transpose(1, 0, 2, 3, 4)
    sm_scale = MLA_QK ** -0.5

    def one_block(qi):
        s = jnp.einsum('bqhd,bkhd->bhqk', qi, k).astype(jnp.float32) * sm_scale
        p = jax.nn.softmax(s, axis=-1).astype(v.dtype)
        return jnp.einsum('bhqk,bkhd->bqhd', p, v)

    o = lax.map(one_block, qb)
    return o.transpose(1, 0, 2, 3, 4).reshape(B, T, H * MLA_V)


def mixer_branches(parts, attn, sc_conv_w, cf_conv_w, cf_conv_b, cf_ln_w, cf_ln_b, cf_pw_w, cf_pw_b):
    _, _, _, g_a, sc_in, sc_b, sc_c, g_b, cf_glu, g_c = parts
    y_a = attn * jax.nn.silu(g_a)
    y_b = sc_b * dwconv(sc_c * sc_in, sc_conv_w) * jax.nn.silu(g_b)
    a, g = jnp.split(cf_glu, 2, axis=-1)
    z = dwconv(a * jax.nn.sigmoid(g), cf_conv_w) + cf_conv_b
    z = jax.nn.silu(layer_norm(z, cf_ln_w, cf_ln_b))
    y_c = (z @ cf_pw_w + cf_pw_b) * jax.nn.silu(g_c)
    return jnp.concatenate([y_a, y_b, y_c], axis=-1)


def setup_inputs(seed: int = 0) -> dict:
    key = jax.random.key(seed)
    ks = jax.random.split(key, 24)
    f32 = jnp.float32
    nrm = lambda k, shape, s: jax.random.normal(k, shape, f32) * s
    return {
        'x': nrm(ks[0], (BATCH, SEQ, D_MODEL), 1.0),
        'c': nrm(ks[1], (BATCH, D_MODEL), 1.0),
        'ctx': nrm(ks[2], (BATCH, CTX_LEN, D_MODEL), 1.0),
        'c_ctx': nrm(ks[3], (D_MODEL,), 1.0),
        'norm_w': 1.0 + nrm(ks[4], (DEPTH, D_MODEL), 0.02),
        'w_mod': nrm(ks[5], (DEPTH, D_MODEL, 3 * D_MODEL), D_MODEL ** -0.5),
        'b_mod': nrm(ks[6], (DEPTH, 3 * D_MODEL), 0.02),
        'w_in': nrm(ks[7], (DEPTH, D_MODEL, D_IN), D_MODEL ** -0.5),
        'q_norm_w': 1.0 + nrm(ks[8], (DEPTH, Q_RANK), 0.02),
        'w_uq': nrm(ks[9], (DEPTH, Q_RANK, MLA_HEADS * MLA_QK), Q_RANK ** -0.5),
        'kv_norm_w': 1.0 + nrm(ks[10], (DEPTH, KV_RANK), 0.02),
        'w_ukv': nrm(ks[11], (DEPTH, KV_RANK, MLA_HEADS * (MLA_NOPE + MLA_V)), KV_RANK ** -0.5),
        'q_head_norm_w': 1.0 + nrm(ks[12], (DEPTH, MLA_QK), 0.02),
        'k_head_norm_w': 1.0 + nrm(ks[13], (DEPTH, MLA_QK), 0.02),
        'sc_conv_w': nrm(ks[14], (DEPTH, SC_K, SC_WIDTH), SC_K ** -0.5),
        'cf_conv_w': nrm(ks[15], (DEPTH, CF_K, CF_WIDTH), CF_K ** -0.5),
        'cf_conv_b': nrm(ks[16], (DEPTH, CF_WIDTH), 0.02),
        'cf_ln_w': 1.0 + nrm(ks[17], (DEPTH, CF_WIDTH), 0.02),
        'cf_ln_b': nrm(ks[18], (DEPTH, CF_WIDTH), 0.02),
        'cf_pw_w': nrm(ks[19], (DEPTH, CF_WIDTH, CF_WIDTH), CF_WIDTH ** -0.5),
        'cf_pw_b': nrm(ks[20], (DEPTH, CF_WIDTH), 0.02),
        'w_out': nrm(ks[21], (DEPTH, D_MIX, D_MODEL), D_MIX ** -0.5),
    }


def reference(x, c, ctx, c_ctx, norm_w, w_mod, b_mod, w_in, q_norm_w, w_uq, kv_norm_w, w_ukv,
              q_head_norm_w, k_head_norm_w, sc_conv_w, cf_conv_w, cf_conv_b, cf_ln_w, cf_ln_b,
              cf_pw_w, cf_pw_b, w_out):
    T = x.shape[1]
    cos, sin = axial_rope_tables(T)
    xc = ctx
    for l in range(DEPTH):
        last = l == DEPTH - 1
        shift, scale, gate = jnp.split(jax.nn.silu(c) @ w_mod[l] + b_mod[l], 3, axis=-1)
        shift_c, scale_c, gate_c = jnp.split(jax.nn.silu(c_ctx) @ w_mod[l] + b_mod[l], 3, axis=-1)
        h = rms_norm(x, norm_w[l]) * (1.0 + scale[:, None, :]) + shift[:, None, :]
        hc = rms_norm(xc, norm_w[l]) * (1.0 + scale_c) + shift_c

        parts = split_in(h @ w_in[l])
        q = mla_q(parts[0], q_norm_w[l], w_uq[l], q_head_norm_w[l], cos, sin)
        k, v = mla_kv(parts[1], parts[2], kv_norm_w[l], w_ukv[l], k_head_norm_w[l], cos, sin)

        if last:
            ckv_c, kr_c = jnp.split(hc @ w_in[l][:, Q_RANK:Q_RANK + KV_RANK + MLA_ROPE], [KV_RANK], axis=-1)
            parts_c = None
        else:
            parts_c = split_in(hc @ w_in[l])
            ckv_c, kr_c = parts_c[1], parts_c[2]
        kc, vc = mla_kv(ckv_c, kr_c, kv_norm_w[l], w_ukv[l], k_head_norm_w[l], None, None)

        attn = attend(q, jnp.concatenate([kc, k], axis=1), jnp.concatenate([vc, v], axis=1))
        y = mixer_branches(parts, attn, sc_conv_w[l], cf_conv_w[l], cf_conv_b[l], cf_ln_w[l],
                           cf_ln_b[l], cf_pw_w[l], cf_pw_b[l])
        x_new = x + gate[:, None, :] * (y @ w_out[l])

        if not last:
            qc = mla_q(parts_c[0], q_norm_w[l], w_uq[l], q_head_norm_w[l], None, None)
            attn_c = attend(qc, kc, vc)
            yc = mixer_branches(parts_c, attn_c, sc_conv_w[l], cf_conv_w[l], cf_conv_b[l], cf_ln_w[l],
                                cf_ln_b[l], cf_pw_w[l], cf_pw_b[l])
            xc = xc + gate_c * (yc @ w_out[l])
        x = x_new
    return x
```

```cpp
#include <hip/hip_runtime.h>
#include <hip/hip_bf16.h>
#include <hip/hip_cooperative_groups.h>
#include <cstdio>
#include <cstdint>
namespace cg = cooperative_groups;

#ifndef ONE_LAUNCH
#define ONE_LAUNCH 1
#endif

constexpr int DM = 1024, NBATCH = 4, TSEQ = 8192, CLEN = 256, DEPTH = 2;
constexpr int NLAT = NBATCH * TSEQ;
constexpr int NCTX = NBATCH * CLEN;
constexpr int NTOK = NLAT + NCTX;
constexpr int DIN = 2720, DINP = 2816;
constexpr int NH = 8, DQK = 96, DV = 64, NKEY = CLEN + TSEQ;
constexpr int U_CQ = 0, U_CKV = 256, U_KR = 384, U_GA = 416, U_SCIN = 928, U_SCB = 1184, U_SCC = 1440, U_GB = 1696,
              U_CFA = 1952, U_CFG = 2208, U_GC = 2464;
constexpr float EPS = 1e-6f, LN_EPS = 1e-5f;
constexpr int NTHR = 512;

constexpr size_t AL(size_t x) { return (x + 255) / 256 * 256; }
constexpr size_t WS_WIN  = 0;
constexpr size_t WS_WUQ  = WS_WIN  + AL((size_t)DEPTH * DINP * DM * 2);
constexpr size_t WS_WUKV = WS_WUQ  + AL((size_t)DEPTH * 768 * 256 * 2);
constexpr size_t WS_WPW  = WS_WUKV + AL((size_t)DEPTH * 1024 * 128 * 2);
constexpr size_t WS_WOUT = WS_WPW  + AL((size_t)DEPTH * 256 * 256 * 2);
constexpr size_t WS_MOD  = WS_WOUT + AL((size_t)DEPTH * DM * DM * 2);
constexpr size_t WS_H    = WS_MOD  + AL((size_t)DEPTH * 5 * 3072 * 4);
constexpr size_t WS_U    = WS_H    + AL((size_t)NTOK * DM * 2);
constexpr size_t WS_Q    = WS_U    + AL((size_t)NTOK * DIN * 2);
constexpr size_t WS_K    = WS_Q    + AL((size_t)NBATCH * NH * NKEY * DQK * 2);
constexpr size_t WS_V    = WS_K    + AL((size_t)NBATCH * NH * NKEY * DQK * 2);
constexpr size_t WS_XC1  = WS_V    + AL((size_t)NBATCH * NH * NKEY * DV * 2);
constexpr size_t WS_END  = WS_XC1  + AL((size_t)NCTX * DM * 4);

constexpr int LDS_BYTES = 116 * 1024;

using bf16x8 = __attribute__((ext_vector_type(8))) short;
using s16x4  = __attribute__((ext_vector_type(4))) short;
using f32x4  = __attribute__((ext_vector_type(4))) float;
using f32x16 = __attribute__((ext_vector_type(16))) float;
using u32x4  = __attribute__((ext_vector_type(4))) unsigned;
using u32x2  = __attribute__((ext_vector_type(2))) unsigned;
typedef unsigned short bfraw;
#define DI __device__ __forceinline__
#define SBAR() __builtin_amdgcn_sched_barrier(0)

DI float bf2f(short s) { return __uint_as_float(((unsigned)(unsigned short)s) << 16); }
DI bfraw f2bf(float x) { unsigned u = __float_as_uint(x); u += 0x7fffu + ((u >> 16) & 1u); return (bfraw)(u >> 16); }
DI unsigned cvtpk(float lo, float hi) { unsigned r; asm volatile("v_cvt_pk_bf16_f32 %0, %1, %2" : "=v"(r) : "v"(lo), "v"(hi)); return r; }
DI u32x2 pack4(float a, float b, float c, float d) { u32x2 r = {cvtpk(a, b), cvtpk(c, d)}; return r; }
DI float silu_f(float x) { return x / (1.f + __expf(-x)); }
DI float sigmoid_f(float x) { return 1.f / (1.f + __expf(-x)); }
DI f32x4 mfma16(bf16x8 a, bf16x8 b, f32x4 c) { return __builtin_amdgcn_mfma_f32_16x16x32_bf16(a, b, c, 0, 0, 0); }

struct Params {
  const float* x; const float* c; const float* ctx; const float* c_ctx; const float* norm_w; const float* w_mod; const float* b_mod;
  const float* w_in; const float* q_norm_w; const float* w_uq; const float* kv_norm_w; const float* w_ukv; const float* q_head_norm_w;
  const float* k_head_norm_w; const float* sc_conv_w; const float* cf_conv_w; const float* cf_conv_b; const float* cf_ln_w;
  const float* cf_ln_b; const float* cf_pw_w; const float* cf_pw_b; const float* w_out;
  float* out; unsigned char* ws; int ph_lo, ph_hi;
};

DI void row_info(int row, int& b, bool& lat, int& pos) {
  if (row < NLAT) { lat = true; b = row >> 13; pos = row & (TSEQ - 1); }
  else { int c = row - NLAT; lat = false; b = c >> 8; pos = c & (CLEN - 1); }
}

DI void transpose_tile(const float* __restrict__ src, bfraw* __restrict__ dst, int K, int N, int k0, int n0, const float* __restrict__ scale, float* tile) {
  const int tid = threadIdx.x;
#pragma unroll
  for (int i = 0; i < 8; ++i) {
    int idx = tid + i * NTHR; int r = idx >> 6, c = idx & 63; int n = n0 + c;
    float v = (n < N) ? src[(long)(k0 + r) * N + n] : 0.f;
    if (scale) v *= scale[k0 + r];
    tile[r * 65 + c] = v;
  }
  __syncthreads();
#pragma unroll
  for (int i = 0; i < 8; ++i) {
    int idx = tid + i * NTHR; int n = idx >> 6, k = idx & 63;
    dst[(long)(n0 + n) * K + k0 + k] = f2bf(tile[k * 65 + n]);
  }
  __syncthreads();
}

DI void p0_prologue(const Params& p, char* lds) {
  float* tile = (float*)lds;
  const int tid = threadIdx.x;
  constexpr int PER_L = 1056, NTR = DEPTH * PER_L, NMOD = DEPTH * 96;
  for (int it = blockIdx.x; it < NTR + NMOD; it += gridDim.x) {
    if (it < NTR) {
      const int l = it / PER_L, r = it % PER_L;
      if (r < 704) { int kt = r / 44, nt = r % 44;
        transpose_tile(p.w_in + (size_t)l * DM * DIN, (bfraw*)(p.ws + WS_WIN) + (size_t)l * DINP * DM, DM, DIN, kt * 64, nt * 64, nullptr, tile); }
      else if (r < 752) { int rr = r - 704, kt = rr / 12, nt = rr % 12;
        transpose_tile(p.w_uq + (size_t)l * 256 * 768, (bfraw*)(p.ws + WS_WUQ) + (size_t)l * 768 * 256, 256, 768, kt * 64, nt * 64, p.q_norm_w + l * 256, tile); }
      else if (r < 784) { int rr = r - 752, kt = rr / 16, nt = rr % 16;
        transpose_tile(p.w_ukv + (size_t)l * 128 * 1024, (bfraw*)(p.ws + WS_WUKV) + (size_t)l * 1024 * 128, 128, 1024, kt * 64, nt * 64, p.kv_norm_w + l * 128, tile); }
      else if (r < 800) { int rr = r - 784, kt = rr / 4, nt = rr % 4;
        transpose_tile(p.cf_pw_w + (size_t)l * 256 * 256, (bfraw*)(p.ws + WS_WPW) + (size_t)l * 256 * 256, 256, 256, kt * 64, nt * 64, nullptr, tile); }
      else { int rr = r - 800, kt = rr / 16, nt = rr % 16;
        transpose_tile(p.w_out + (size_t)l * DM * DM, (bfraw*)(p.ws + WS_WOUT) + (size_t)l * DM * DM, DM, DM, kt * 64, nt * 64, nullptr, tile); }
    } else {
      const int m = it - NTR, l = m / 96, j0 = (m % 96) * 32;
      float* sl = (float*)lds;
      float* red = sl + 5 * 1024;
      for (int idx = tid; idx < 5 * 1024; idx += NTHR) {
        int r = idx >> 10, k = idx & 1023; float v = (r < 4) ? p.c[r * 1024 + k] : p.c_ctx[k]; sl[idx] = silu_f(v);
      }
      __syncthreads();
      const int col = tid & 31, kg = tid >> 5;
      float a0 = 0, a1 = 0, a2 = 0, a3 = 0, a4 = 0;
      const float* wm = p.w_mod + ((size_t)l * 1024 + kg * 64) * 3072 + j0 + col;
      for (int kk = 0; kk < 64; ++kk) {
        float w = wm[(size_t)kk * 3072]; int k = kg * 64 + kk;
        a0 += sl[k] * w; a1 += sl[1024 + k] * w; a2 += sl[2048 + k] * w; a3 += sl[3072 + k] * w; a4 += sl[4096 + k] * w;
      }
      red[(kg * 5 + 0) * 32 + col] = a0; red[(kg * 5 + 1) * 32 + col] = a1; red[(kg * 5 + 2) * 32 + col] = a2;
      red[(kg * 5 + 3) * 32 + col] = a3; red[(kg * 5 + 4) * 32 + col] = a4;
      __syncthreads();
      if (tid < 160) {
        int r = tid >> 5, cc = tid & 31; float s = p.b_mod[l * 3072 + j0 + cc];
        for (int g = 0; g < 16; ++g) s += red[(g * 5 + r) * 32 + cc];
        ((float*)(p.ws + WS_MOD))[(l * 5 + r) * 3072 + j0 + cc] = s;
      }
      __syncthreads();
    }
  }
}

DI void pa_norm(const Params& p, int l) {
  const int lane = threadIdx.x & 63, wid = threadIdx.x >> 6;
  const float* xl = (l == 0) ? p.x : p.out;
  const float* xc = (l == 0) ? p.ctx : (const float*)(p.ws + WS_XC1);
  const float* mod = (const float*)(p.ws + WS_MOD) + (size_t)l * 5 * 3072;
  const float* nw = p.norm_w + l * DM;
  bfraw* H = (bfraw*)(p.ws + WS_H);
  for (int row = blockIdx.x * 8 + wid; row < NTOK; row += gridDim.x * 8) {
    int b, pos; bool lat; row_info(row, b, lat, pos);
    const float* src = lat ? xl + (size_t)row * DM : xc + (size_t)(row - NLAT) * DM;
    const float* mr = mod + (lat ? b : 4) * 3072;
    f32x4 v[4]; float ss = 0.f;
#pragma unroll
    for (int i = 0; i < 4; ++i) { v[i] = *(const f32x4*)(src + i * 256 + lane * 4); ss += v[i][0] * v[i][0] + v[i][1] * v[i][1] + v[i][2] * v[i][2] + v[i][3] * v[i][3]; }
#pragma unroll
    for (int o = 32; o >= 1; o >>= 1) ss += __shfl_xor(ss, o);
    const float r = rsqrtf(ss * (1.f / DM) + EPS);
#pragma unroll
    for (int i = 0; i < 4; ++i) {
      const int k = i * 256 + lane * 4;
      f32x4 w = *(const f32x4*)(nw + k), sh = *(const f32x4*)(mr + k), sc = *(const f32x4*)(mr + 1024 + k);
      float h0 = v[i][0] * r * w[0] * (1.f + sc[0]) + sh[0], h1 = v[i][1] * r * w[1] * (1.f + sc[1]) + sh[1];
      float h2 = v[i][2] * r * w[2] * (1.f + sc[2]) + sh[2], h3 = v[i][3] * r * w[3] * (1.f + sc[3]) + sh[3];
      *(u32x2*)(H + (size_t)row * DM + k) = pack4(h0, h1, h2, h3);
    }
  }
}

constexpr int G_PITCH = 144, G_ABYTES = 128 * G_PITCH, G_BBYTES = 256 * G_PITCH, G_STAGE = G_ABYTES + G_BBYTES;
template <class Epi>
DI void gemm_tile(const bfraw* __restrict__ A, int lda, const bfraw* __restrict__ Bt, int ldb, int K, int m0, int n0, char* lds, Epi epi) {
  const int tid = threadIdx.x, lane = tid & 63, wid = tid >> 6, wm = wid >> 2, wn = wid & 3, l15 = lane & 15, quad = lane >> 4;
  f32x4 acc[4][4];
#pragma unroll
  for (int i = 0; i < 4; ++i)
#pragma unroll
    for (int j = 0; j < 4; ++j) acc[i][j] = f32x4{0.f, 0.f, 0.f, 0.f};
  const int srow = tid >> 3, skc = tid & 7;
  const bfraw* Ag = A + (size_t)(m0 + srow) * lda + skc * 8;
  const bfraw* Bg = Bt + (size_t)(n0 + srow) * ldb + skc * 8;
  bf16x8 ra0, ra1, rb0, rb1, rb2, rb3;
#define GLOAD(k0) do { ra0 = *(const bf16x8*)(Ag + (k0)); ra1 = *(const bf16x8*)(Ag + (size_t)64 * lda + (k0)); \
    rb0 = *(const bf16x8*)(Bg + (k0)); rb1 = *(const bf16x8*)(Bg + (size_t)64 * ldb + (k0)); \
    rb2 = *(const bf16x8*)(Bg + (size_t)128 * ldb + (k0)); rb3 = *(const bf16x8*)(Bg + (size_t)192 * ldb + (k0)); } while (0)
#define SWRITE(s) do { char* _b = lds + (s) * G_STAGE + srow * G_PITCH + skc * 16; \
    *(bf16x8*)(_b) = ra0; *(bf16x8*)(_b + 64 * G_PITCH) = ra1; \
    *(bf16x8*)(_b + G_ABYTES) = rb0; *(bf16x8*)(_b + G_ABYTES + 64 * G_PITCH) = rb1; \
    *(bf16x8*)(_b + G_ABYTES + 128 * G_PITCH) = rb2; *(bf16x8*)(_b + G_ABYTES + 192 * G_PITCH) = rb3; } while (0)
  GLOAD(0); SWRITE(0); __syncthreads();
  const int nk = K >> 6;
  for (int kt = 0; kt < nk; ++kt) {
    if (kt + 1 < nk) GLOAD((kt + 1) * 64);
    const char* base = lds + (kt & 1) * G_STAGE;
    const char* ap = base + (wm * 64 + l15) * G_PITCH + quad * 16;
    const char* bp = base + G_ABYTES + (wn * 64 + l15) * G_PITCH + quad * 16;
#pragma unroll
    for (int ks = 0; ks < 2; ++ks) {
      bf16x8 af[4], bfr[4];
#pragma unroll
      for (int mi = 0; mi < 4; ++mi) af[mi] = *(const bf16x8*)(ap + mi * 16 * G_PITCH + ks * 64);
#pragma unroll
      for (int ni = 0; ni < 4; ++ni) bfr[ni] = *(const bf16x8*)(bp + ni * 16 * G_PITCH + ks * 64);
#pragma unroll
      for (int ni = 0; ni < 4; ++ni)
#pragma unroll
        for (int mi = 0; mi < 4; ++mi) acc[ni][mi] = mfma16(bfr[ni], af[mi], acc[ni][mi]);
    }
    if (kt + 1 < nk) SWRITE((kt + 1) & 1);
    __syncthreads();
  }
#undef GLOAD
#undef SWRITE
#pragma unroll
  for (int ni = 0; ni < 4; ++ni)
#pragma unroll
    for (int mi = 0; mi < 4; ++mi) epi(m0 + wm * 64 + mi * 16 + l15, n0 + wn * 64 + ni * 16 + quad * 4, acc[ni][mi]);
}

DI void pb_inproj(const Params& p, int l, char* lds) {
  const bfraw* H = (const bfraw*)(p.ws + WS_H);
  const bfraw* W = (const bfraw*)(p.ws + WS_WIN) + (size_t)l * DINP * DM;
  bfraw* U = (bfraw*)(p.ws + WS_U);
  constexpr int NT_N = DINP / 256, NT_M = NTOK / 128;
  for (int t = blockIdx.x; t < NT_M * NT_N; t += gridDim.x) {
    const int mt = t / NT_N, nt = t % NT_N;
    gemm_tile(H, DM, W, DM, DM, mt * 128, nt * 256, lds, [&](int m, int n, f32x4 v) {
      if (n < DIN) *(u32x2*)(U + (size_t)m * DIN + n) = pack4(v[0], v[1], v[2], v[3]);
    });
  }
}

DI void pe_outproj(const Params& p, int l, char* lds) {
  const bfraw* Y = (const bfraw*)(p.ws + WS_H);
  const bfraw* W = (const bfraw*)(p.ws + WS_WOUT) + (size_t)l * DM * DM;
  const float* mod = (const float*)(p.ws + WS_MOD) + (size_t)l * 5 * 3072 + 2048;
  const float* xl = (l == 0) ? p.x : p.out;
  const float* xc = p.ctx;
  float* ol = p.out; float* oc = (float*)(p.ws + WS_XC1);
  const int nrows = (l == DEPTH - 1) ? NLAT : NTOK;
  const int ntile = (nrows / 128) * 4;
  for (int t = blockIdx.x; t < ntile; t += gridDim.x) {
    const int mt = t >> 2, nt = t & 3;
    gemm_tile(Y, DM, W, DM, DM, mt * 128, nt * 256, lds, [&](int m, int n, f32x4 v) {
      const bool lat = m < NLAT;
      const int mr = lat ? (m >> 13) : 4;
      const f32x4 g = *(const f32x4*)(mod + mr * 3072 + n);
      const float* xs = lat ? xl + (size_t)m * DM + n : xc + (size_t)(m - NLAT) * DM + n;
      float* od = lat ? ol + (size_t)m * DM + n : oc + (size_t)(m - NLAT) * DM + n;
      const f32x4 xr = *(const f32x4*)xs;
      f32x4 o = {xr[0] + g[0] * v[0], xr[1] + g[1] * v[1], xr[2] + g[2] * v[2], xr[3] + g[3] * v[3]};
      *(f32x4*)od = o;
    });
  }
}

DI void rows_rms(const char* tile, int pitchB, int nchunk_per_lane, float inv_n, float* out) {
  const int lane = threadIdx.x & 63, wid = threadIdx.x >> 6;
  const int row = wid * 8 + (lane >> 3), part = lane & 7;
  float ss = 0.f;
  for (int i = 0; i < nchunk_per_lane; ++i) {
    bf16x8 v = *(const bf16x8*)(tile + row * pitchB + (part + i * 8) * 16);
#pragma unroll
    for (int j = 0; j < 8; ++j) { float f = bf2f(v[j]); ss += f * f; }
  }
  ss += __shfl_xor(ss, 4); ss += __shfl_xor(ss, 2); ss += __shfl_xor(ss, 1);
  if (part == 0) out[row] = rsqrtf(ss * inv_n + EPS);
}

DI void rope_cs(int pos, int d, float& c, float& s) {
  const float pp = (float)((d < 8) ? (pos >> 6) : (pos & 63));
  const float inv = exp2f(-(float)(d & 7) * 1.6609640474436813f);
  const float ang = pp * inv;
  c = __cosf(ang); s = __sinf(ang);
}

DI void pc_q(const Params& p, int l, char* lds) {
  const int tid = threadIdx.x, lane = tid & 63, h = tid >> 6, l15 = lane & 15, quad = lane >> 4;
  constexpr int PB_ = 528;
  char* At = lds; float* rq = (float*)(lds + 64 * PB_);
  const bfraw* U = (const bfraw*)(p.ws + WS_U);
  const bfraw* W = (const bfraw*)(p.ws + WS_WUQ) + (size_t)l * 768 * 256;
  bfraw* Q = (bfraw*)(p.ws + WS_Q);
  const float* wh = p.q_head_norm_w + l * DQK;
  const int ntile = ((l == DEPTH - 1) ? NLAT : NTOK) / 64;
  for (int t = blockIdx.x; t < ntile; t += gridDim.x) {
    const int m0 = t * 64;
#pragma unroll
    for (int i = 0; i < 4; ++i) { int c = tid + i * NTHR, row = c >> 5, kc = c & 31;
      *(bf16x8*)(At + row * PB_ + kc * 16) = *(const bf16x8*)(U + (size_t)(m0 + row) * DIN + U_CQ + kc * 8); }
    __syncthreads();
    rows_rms(At, PB_, 4, 1.f / 256.f, rq);
    __syncthreads();
    f32x4 acc[6][4];
#pragma unroll
    for (int i = 0; i < 6; ++i)
#pragma unroll
      for (int j = 0; j < 4; ++j) acc[i][j] = f32x4{0.f, 0.f, 0.f, 0.f};
    const bfraw* Wp = W + (size_t)(h * 96 + l15) * 256 + quad * 8;
    const char* ap = At + l15 * PB_ + quad * 16;
#pragma unroll 2
    for (int ks = 0; ks < 8; ++ks) {
      bf16x8 bfr[6], af[4];
#pragma unroll
      for (int ni = 0; ni < 6; ++ni) bfr[ni] = *(const bf16x8*)(Wp + ni * 16 * 256 + ks * 32);
#pragma unroll
      for (int mi = 0; mi < 4; ++mi) af[mi] = *(const bf16x8*)(ap + mi * 16 * PB_ + ks * 64);
#pragma unroll
      for (int ni = 0; ni < 6; ++ni)
#pragma unroll
        for (int mi = 0; mi < 4; ++mi) acc[ni][mi] = mfma16(bfr[ni], af[mi], acc[ni][mi]);
    }
    float whv[6][4];
#pragma unroll
    for (int ni = 0; ni < 6; ++ni)
#pragma unroll
      for (int j = 0; j < 4; ++j) whv[ni][j] = wh[ni * 16 + quad * 4 + j];
#pragma unroll
    for (int mi = 0; mi < 4; ++mi) {
      const int row = m0 + mi * 16 + l15; int b, pos; bool lat; row_info(row, b, lat, pos);
      const float r = rq[mi * 16 + l15];
      float ss = 0.f;
#pragma unroll
      for (int ni = 0; ni < 6; ++ni)
#pragma unroll
        for (int j = 0; j < 4; ++j) { float y = acc[ni][mi][j] * r; ss += y * y; }
      ss += __shfl_xor(ss, 16); ss += __shfl_xor(ss, 32);
      const float f = r * rsqrtf(ss * (1.f / DQK) + EPS);
      float val[6][4];
#pragma unroll
      for (int ni = 0; ni < 6; ++ni)
#pragma unroll
        for (int j = 0; j < 4; ++j) val[ni][j] = acc[ni][mi][j] * f * whv[ni][j];
      if (lat) {
#pragma unroll
        for (int j = 0; j < 4; ++j) { float c, s; rope_cs(pos, quad * 4 + j, c, s);
          float x1 = val[4][j], x2 = val[5][j]; val[4][j] = x1 * c - x2 * s; val[5][j] = x2 * c + x1 * s; }
      }
      const int qrow = lat ? CLEN + pos : pos;
      bfraw* qd = Q + ((size_t)(b * NH + h) * NKEY + qrow) * DQK + quad * 4;
#pragma unroll
      for (int ni = 0; ni < 6; ++ni) *(u32x2*)(qd + ni * 16) = pack4(val[ni][0], val[ni][1], val[ni][2], val[ni][3]);
    }
    __syncthreads();
  }
}

DI void pc_kv(const Params& p, int l, char* lds) {
  const int tid = threadIdx.x, lane = tid & 63, h = tid >> 6, l15 = lane & 15, quad = lane >> 4;
  constexpr int PB_ = 336;
  char* At = lds; float* rkv = (float*)(lds + 64 * PB_);
  const bfraw* U = (const bfraw*)(p.ws + WS_U);
  const bfraw* W = (const bfraw*)(p.ws + WS_WUKV) + (size_t)l * 1024 * 128;
  bfraw* Kd = (bfraw*)(p.ws + WS_K); bfraw* Vd = (bfraw*)(p.ws + WS_V);
  const float* wh = p.k_head_norm_w + l * DQK;
  const int ntile = NTOK / 64;
  for (int t = (blockIdx.x + gridDim.x - (int)(gridDim.x / 3)) % gridDim.x; t < ntile; t += gridDim.x) {
    const int m0 = t * 64;
    for (int c = tid; c < 64 * 20; c += NTHR) { int row = c / 20, kc = c % 20;
      *(bf16x8*)(At + row * PB_ + kc * 16) = *(const bf16x8*)(U + (size_t)(m0 + row) * DIN + U_CKV + kc * 8); }
    __syncthreads();
    rows_rms(At, PB_, 2, 1.f / 128.f, rkv);
    __syncthreads();
    const char* ap = At + l15 * PB_ + quad * 16;
#pragma unroll
    for (int pass = 0; pass < 2; ++pass) {
      f32x4 acc[4][4];
#pragma unroll
      for (int i = 0; i < 4; ++i)
#pragma unroll
        for (int j = 0; j < 4; ++j) acc[i][j] = f32x4{0.f, 0.f, 0.f, 0.f};
      const bfraw* Wp = W + (size_t)(h * 128 + pass * 64 + l15) * 128 + quad * 8;
#pragma unroll
      for (int ks = 0; ks < 4; ++ks) {
        bf16x8 bfr[4], af[4];
#pragma unroll
        for (int ni = 0; ni < 4; ++ni) bfr[ni] = *(const bf16x8*)(Wp + ni * 16 * 128 + ks * 32);
#pragma unroll
        for (int mi = 0; mi < 4; ++mi) af[mi] = *(const bf16x8*)(ap + mi * 16 * PB_ + ks * 64);
#pragma unroll
        for (int ni = 0; ni < 4; ++ni)
#pragma unroll
          for (int mi = 0; mi < 4; ++mi) acc[ni][mi] = mfma16(bfr[ni], af[mi], acc[ni][mi]);
      }
#pragma unroll
      for (int mi = 0; mi < 4; ++mi) {
        const int row = m0 + mi * 16 + l15; int b, pos; bool lat; row_info(row, b, lat, pos);
        const float r = rkv[mi * 16 + l15];
        const int key = lat ? CLEN + pos : pos;
        if (pass == 0) {
          const s16x4 k1 = *(const s16x4*)(At + (mi * 16 + l15) * PB_ + (128 + quad * 4) * 2);
          const s16x4 k2 = *(const s16x4*)(At + (mi * 16 + l15) * PB_ + (144 + quad * 4) * 2);
          float ss = 0.f;
#pragma unroll
          for (int ni = 0; ni < 4; ++ni)
#pragma unroll
            for (int j = 0; j < 4; ++j) { float y = acc[ni][mi][j] * r; ss += y * y; }
          float kr1[4], kr2[4];
#pragma unroll
          for (int j = 0; j < 4; ++j) { kr1[j] = bf2f(k1[j]); kr2[j] = bf2f(k2[j]); ss += kr1[j] * kr1[j] + kr2[j] * kr2[j]; }
          ss += __shfl_xor(ss, 16); ss += __shfl_xor(ss, 32);
          const float rinv = rsqrtf(ss * (1.f / DQK) + EPS);
          const float f = r * rinv;
          bfraw* kd = Kd + ((size_t)(b * NH + h) * NKEY + key) * DQK + quad * 4;
#pragma unroll
          for (int ni = 0; ni < 4; ++ni) {
            const int n = ni * 16 + quad * 4;
            *(u32x2*)(kd + ni * 16) = pack4(acc[ni][mi][0] * f * wh[n], acc[ni][mi][1] * f * wh[n + 1], acc[ni][mi][2] * f * wh[n + 2], acc[ni][mi][3] * f * wh[n + 3]);
          }
          float x1[4], x2[4];
#pragma unroll
          for (int j = 0; j < 4; ++j) {
            const int d = quad * 4 + j;
            float a = kr1[j] * rinv * wh[64 + d], bb = kr2[j] * rinv * wh[80 + d];
            if (lat) { float c, s; rope_cs(pos, d, c, s); x1[j] = a * c - bb * s; x2[j] = bb * c + a * s; }
            else { x1[j] = a; x2[j] = bb; }
          }
          *(u32x2*)(kd + 64) = pack4(x1[0], x1[1], x1[2], x1[3]);
          *(u32x2*)(kd + 80) = pack4(x2[0], x2[1], x2[2], x2[3]);
        } else {
          bfraw* vd = Vd + ((size_t)(b * NH + h) * NKEY + key) * DV + quad * 4;
#pragma unroll
          for (int ni = 0; ni < 4; ++ni)
            *(u32x2*)(vd + ni * 16) = pack4(acc[ni][mi][0] * r, acc[ni][mi][1] * r, acc[ni][mi][2] * r, acc[ni][mi][3] * r);
        }
      }
    }
    __syncthreads();
  }
}

DI void pc_conv(const Params& p, int l, char* lds) {
  const int tid = threadIdx.x, lane = tid & 63, wid = tid >> 6, l15 = lane & 15, quad = lane >> 4;
  const bfraw* U = (const bfraw*)(p.ws + WS_U);
  bfraw* Y = (bfraw*)(p.ws + WS_H);
  const bfraw* Wpw = (const bfraw*)(p.ws + WS_WPW) + (size_t)l * 256 * 256;
  const float* scw = p.sc_conv_w + l * 3 * 256;
  const float* cfw = p.cf_conv_w + l * 31 * 256;
  const float* cfb = p.cf_conv_b + l * 256;
  const float* lnw = p.cf_ln_w + l * 256; const float* lnb = p.cf_ln_b + l * 256;
  const float* pwb = p.cf_pw_b + l * 256;
  bfraw* G = (bfraw*)lds;
  constexpr int APB = 528;
  float* Z = (float*)(lds + 48128);
  const int ntile = ((l == DEPTH - 1) ? NLAT : NTOK) / 64;
  for (int t = (blockIdx.x + gridDim.x - (int)(2 * gridDim.x / 3)) % gridDim.x; t < ntile; t += gridDim.x) {
    const int tok0 = t * 64; int b, pos0; bool lat; row_info(tok0, b, lat, pos0);
    const int seq0 = tok0 - pos0, slen = lat ? TSEQ : CLEN;
#pragma unroll 1
    for (int i = 0; i < 4; ++i) {
      const int idx = tid + i * NTHR, tt = idx >> 5, c8 = (idx & 31) * 8, row = tok0 + tt, pos = pos0 + tt;
      const bfraw* ur = U + (size_t)row * DIN;
      bf16x8 ci = *(const bf16x8*)(ur + U_SCIN + c8), cc = *(const bf16x8*)(ur + U_SCC + c8);
      bf16x8 cb = *(const bf16x8*)(ur + U_SCB + c8), gb = *(const bf16x8*)(ur + U_GB + c8);
      bf16x8 pi = ci, pc = cc, ni_ = ci, nc = cc;
      const bool hp = pos > 0, hn = pos < slen - 1;
      if (hp) { pi = *(const bf16x8*)(ur - DIN + U_SCIN + c8); pc = *(const bf16x8*)(ur - DIN + U_SCC + c8); }
      if (hn) { ni_ = *(const bf16x8*)(ur + DIN + U_SCIN + c8); nc = *(const bf16x8*)(ur + DIN + U_SCC + c8); }
      float o[8];
#pragma unroll
      for (int j = 0; j < 8; ++j) {
        const int c = c8 + j;
        float pp = hp ? bf2f(pi[j]) * bf2f(pc[j]) : 0.f, pn = hn ? bf2f(ni_[j]) * bf2f(nc[j]) : 0.f, p0 = bf2f(ci[j]) * bf2f(cc[j]);
        float cv = scw[c] * pp + scw[256 + c] * p0 + scw[512 + c] * pn;
        o[j] = bf2f(cb[j]) * cv * silu_f(bf2f(gb[j]));
      }
      u32x4 w = {cvtpk(o[0], o[1]), cvtpk(o[2], o[3]), cvtpk(o[4], o[5]), cvtpk(o[6], o[7])};
      *(u32x4*)(Y + (size_t)row * DM + 512 + c8) = w;
    }
#pragma unroll 1
    for (int idx = tid; idx < 94 * 32; idx += NTHR) {
      const int rr = idx >> 5, c8 = (idx & 31) * 8, pos = pos0 - 15 + rr;
      u32x4 w = {0u, 0u, 0u, 0u};
      if (pos >= 0 && pos < slen) {
        const bfraw* ur = U + (size_t)(seq0 + pos) * DIN;
        bf16x8 a = *(const bf16x8*)(ur + U_CFA + c8), g = *(const bf16x8*)(ur + U_CFG + c8);
        float o[8];
#pragma unroll
        for (int j = 0; j < 8; ++j) o[j] = bf2f(a[j]) * sigmoid_f(bf2f(g[j]));
        w = u32x4{cvtpk(o[0], o[1]), cvtpk(o[2], o[3]), cvtpk(o[4], o[5]), cvtpk(o[6], o[7])};
      }
      *(u32x4*)(G + rr * 256 + c8) = w;
    }
    __syncthreads();
    {
      const int c = tid & 255, half = tid >> 8;
      float w[31];
#pragma unroll
      for (int k = 0; k < 31; ++k) w[k] = cfw[k * 256 + c];
      const float bias = cfb[c];
#pragma unroll 1
      for (int o0 = 0; o0 < 32; o0 += 4) {
        float a0 = bias, a1 = bias, a2 = bias, a3 = bias;
        const bfraw* gp = G + (half * 32 + o0) * 256 + c;
#pragma unroll
        for (int i = 0; i < 34; ++i) {
          const float v = bf2f((short)gp[i * 256]);
          if (i < 31) a0 += w[i] * v;
          if (i >= 1 && i < 32) a1 += w[i - 1] * v;
          if (i >= 2 && i < 33) a2 += w[i - 2] * v;
          if (i >= 3) a3 += w[i - 3] * v;
        }
        float* zp = Z + (half * 32 + o0) * 260 + c;
        zp[0] = a0; zp[260] = a1; zp[520] = a2; zp[780] = a3;
      }
    }
    __syncthreads();
    {
      f32x4 lw = *(const f32x4*)(lnw + lane * 4), lb = *(const f32x4*)(lnb + lane * 4);
#pragma unroll 1
      for (int i = 0; i < 8; ++i) {
        const int tt = wid * 8 + i;
        f32x4 z = *(const f32x4*)(Z + tt * 260 + lane * 4);
        float s = z[0] + z[1] + z[2] + z[3];
#pragma unroll
        for (int o = 32; o >= 1; o >>= 1) s += __shfl_xor(s, o);
        const float mu = s * (1.f / 256.f);
        float d0 = z[0] - mu, d1 = z[1] - mu, d2 = z[2] - mu, d3 = z[3] - mu;
        float q = d0 * d0 + d1 * d1 + d2 * d2 + d3 * d3;
#pragma unroll
        for (int o = 32; o >= 1; o >>= 1) q += __shfl_xor(q, o);
        const float rs = rsqrtf(q * (1.f / 256.f) + LN_EPS);
        float y0 = silu_f(d0 * rs * lw[0] + lb[0]), y1 = silu_f(d1 * rs * lw[1] + lb[1]);
        float y2 = silu_f(d2 * rs * lw[2] + lb[2]), y3 = silu_f(d3 * rs * lw[3] + lb[3]);
        *(u32x2*)((char*)G + tt * APB + lane * 8) = pack4(y0, y1, y2, y3);
      }
    }
    __syncthreads();
    {
      f32x4 acc[2][4];
#pragma unroll
      for (int i = 0; i < 2; ++i)
#pragma unroll
        for (int j = 0; j < 4; ++j) acc[i][j] = f32x4{0.f, 0.f, 0.f, 0.f};
      const bfraw* Wp = Wpw + (size_t)(wid * 32 + l15) * 256 + quad * 8;
      const char* ap = (const char*)G + l15 * APB + quad * 16;
#pragma unroll 2
      for (int ks = 0; ks < 8; ++ks) {
        bf16x8 bfr[2], af[4];
#pragma unroll
        for (int ni = 0; ni < 2; ++ni) bfr[ni] = *(const bf16x8*)(Wp + ni * 16 * 256 + ks * 32);
#pragma unroll
        for (int mi = 0; mi < 4; ++mi) af[mi] = *(const bf16x8*)(ap + mi * 16 * APB + ks * 64);
#pragma unroll
        for (int ni = 0; ni < 2; ++ni)
#pragma unroll
          for (int mi = 0; mi < 4; ++mi) acc[ni][mi] = mfma16(bfr[ni], af[mi], acc[ni][mi]);
      }
#pragma unroll
      for (int ni = 0; ni < 2; ++ni) {
        const int n = wid * 32 + ni * 16 + quad * 4;
        const f32x4 pb = *(const f32x4*)(pwb + n);
#pragma unroll
        for (int mi = 0; mi < 4; ++mi) {
          const int row = tok0 + mi * 16 + l15;
          const s16x4 gc = *(const s16x4*)(U + (size_t)row * DIN + U_GC + n);
          float y0 = (acc[ni][mi][0] + pb[0]) * silu_f(bf2f(gc[0])), y1 = (acc[ni][mi][1] + pb[1]) * silu_f(bf2f(gc[1]));
          float y2 = (acc[ni][mi][2] + pb[2]) * silu_f(bf2f(gc[2])), y3 = (acc[ni][mi][3] + pb[3]) * silu_f(bf2f(gc[3]));
          *(u32x2*)(Y + (size_t)row * DM + 768 + n) = pack4(y0, y1, y2, y3);
        }
      }
    }
    __syncthreads();
  }
}

constexpr float ATT_SCALE = 0.10206207261596575f;
constexpr float ATT_THR = 8.f;
constexpr int SHM_V = 64 * 64 * 2, SHM_K = 64 * 256;
#define KSWZ(row, colB) ((row) * 256 + ((colB) ^ (((row) & 7) << 4)))
DI int crow(int r, int hi) { return (r & 3) + 8 * (r >> 2) + 4 * hi; }

DI void partialSM(f32x16& p0, f32x16& p1, float& m_reg, float& mn, float& alpha) {
  constexpr float C = ATT_SCALE * 1.4426950408889634f;
  float pmax = p0[0];
#pragma unroll
  for (int r = 1; r < 16; ++r) pmax = fmaxf(pmax, p0[r]);
#pragma unroll
  for (int r = 0; r < 16; ++r) pmax = fmaxf(pmax, p1[r]);
  { auto rr = __builtin_amdgcn_permlane32_swap(__float_as_uint(pmax), __float_as_uint(pmax), false, false);
    pmax = fmaxf(__uint_as_float(rr[0]), __uint_as_float(rr[1])); }
  if (__builtin_expect(__all(pmax - m_reg <= ATT_THR / ATT_SCALE), 1)) { mn = m_reg; alpha = 1.f; }
  else { mn = fmaxf(m_reg, pmax); alpha = __builtin_amdgcn_exp2f((m_reg - mn) * C); m_reg = mn; }
  float mnC = -mn * C;
#pragma unroll
  for (int r = 0; r < 16; ++r) p0[r] = fmaf(p0[r], C, mnC);
#pragma unroll
  for (int r = 0; r < 16; ++r) p1[r] = fmaf(p1[r], C, mnC);
#pragma unroll
  for (int r = 0; r < 16; ++r) p0[r] = __builtin_amdgcn_exp2f(p0[r]);
}
DI void finishSM(f32x16& p0, f32x16& p1, float alpha, float& l_reg, bf16x8& pa0, bf16x8& pa1, bf16x8& pa2, bf16x8& pa3) {
#pragma unroll
  for (int r = 0; r < 16; ++r) p1[r] = __builtin_amdgcn_exp2f(p1[r]);
  float ps = 0;
#pragma unroll
  for (int r = 0; r < 16; ++r) ps += p0[r];
#pragma unroll
  for (int r = 0; r < 16; ++r) ps += p1[r];
  { auto rr = __builtin_amdgcn_permlane32_swap(__float_as_uint(ps), __float_as_uint(ps), false, false);
    ps = __uint_as_float(rr[0]) + __uint_as_float(rr[1]); }
  l_reg = l_reg * alpha + ps;
#define PK4(P, BASE, OUT) do { unsigned a0 = cvtpk(P[BASE + 0], P[BASE + 1]), a1 = cvtpk(P[BASE + 2], P[BASE + 3]);   \
    unsigned b0 = cvtpk(P[BASE + 4], P[BASE + 5]), b1 = cvtpk(P[BASE + 6], P[BASE + 7]);                              \
    auto r0 = __builtin_amdgcn_permlane32_swap(a0, b0, false, false); auto r1 = __builtin_amdgcn_permlane32_swap(a1, b1, false, false); \
    u32x4 w = {r0[0], r1[0], r0[1], r1[1]}; OUT = *reinterpret_cast<bf16x8*>(&w); } while (0)
  PK4(p0, 0, pa0); PK4(p0, 8, pa1); PK4(p1, 0, pa2); PK4(p1, 8, pa3);
#undef PK4
}
DI void qkt(f32x16& p0, f32x16& p1, const char* Ks, const bf16x8* qr, int r32, int hi) {
  p0 = f32x16{}; p1 = f32x16{};
#pragma unroll
  for (int d0 = 0; d0 < 6; ++d0) { int cb = (d0 * 16 + hi * 8) * 2;
    bf16x8 b0 = *reinterpret_cast<const bf16x8*>(Ks + KSWZ(r32, cb));
    bf16x8 b1 = *reinterpret_cast<const bf16x8*>(Ks + KSWZ(32 + r32, cb));
    p0 = __builtin_amdgcn_mfma_f32_32x32x16_bf16(b0, qr[d0], p0, 0, 0, 0);
    p1 = __builtin_amdgcn_mfma_f32_32x32x16_bf16(b1, qr[d0], p1, 0, 0, 0); }
}
DI int v_st(int k, int c) { const int kk = (k & ~0xC) | ((k & 4) << 1) | ((k & 8) >> 1); return ((kk >> 3) * 2 + (c >> 5)) * 512 + ((kk & 7) * 32 + (c & 31)) * 2; }
DI int v_rd_base(int lane) { return ((lane & 3) << 3) | (((lane >> 2) & 3) << 6) | (((lane >> 4) & 1) << 5) | (((lane >> 5) & 1) << 8); }
constexpr int v_rd_off(int d0, int ks, int half) { return d0 * 512 + ks * 2048 + half * 1024; }
template <int OFF> DI s16x4 tr_read(int vb) {
  s16x4 r; asm volatile("ds_read_b64_tr_b16 %0, %1 offset:%2" : "=&v"(r) : "v"(vb), "i"(OFF) : "memory"); return r;
}
template <int D0> DI void pv_one(f32x16& od, int vb, bf16x8 pa0, bf16x8 pa1, bf16x8 pa2, bf16x8 pa3) {
  const s16x4 l0 = tr_read<v_rd_off(D0, 0, 0)>(vb), h0 = tr_read<v_rd_off(D0, 0, 1)>(vb), l1 = tr_read<v_rd_off(D0, 1, 0)>(vb), h1 = tr_read<v_rd_off(D0, 1, 1)>(vb);
  const s16x4 l2 = tr_read<v_rd_off(D0, 2, 0)>(vb), h2 = tr_read<v_rd_off(D0, 2, 1)>(vb), l3 = tr_read<v_rd_off(D0, 3, 0)>(vb), h3 = tr_read<v_rd_off(D0, 3, 1)>(vb);
  asm volatile("s_waitcnt lgkmcnt(0)" ::: "memory"); SBAR();
#define PK(L, H) (bf16x8){L[0], L[1], L[2], L[3], H[0], H[1], H[2], H[3]}
  od = __builtin_amdgcn_mfma_f32_32x32x16_bf16(pa0, PK(l0, h0), od, 0, 0, 0);
  od = __builtin_amdgcn_mfma_f32_32x32x16_bf16(pa1, PK(l1, h1), od, 0, 0, 0);
  od = __builtin_amdgcn_mfma_f32_32x32x16_bf16(pa2, PK(l2, h2), od, 0, 0, 0);
  od = __builtin_amdgcn_mfma_f32_32x32x16_bf16(pa3, PK(l3, h3), od, 0, 0, 0);
#undef PK
}
DI void pv_d0(f32x16* o, int vb, bf16x8 pa0, bf16x8 pa1, bf16x8 pa2, bf16x8 pa3) {
  pv_one<0>(o[0], vb, pa0, pa1, pa2, pa3); pv_one<1>(o[1], vb, pa0, pa1, pa2, pa3);
}

DI void attn_body(const bfraw* __restrict__ Qb, const bfraw* __restrict__ Kh, const bfraw* __restrict__ Vh, int seq, char* lds,
                  const bfraw* __restrict__ U, bfraw* __restrict__ Y, int orow0, int h) {
  const int tid = threadIdx.x, wid = tid >> 6, lane = tid & 63, r32 = lane & 31, hi = lane >> 5;
  char* V_lds = lds; char* K_lds = lds + 2 * SHM_V;
  float* ws = (float*)(lds + 2 * SHM_V + 2 * SHM_K) + wid * 64; float* li_l = ws; float* al_l = ws + 32;
  float m_reg = -1e30f, l_reg = 0; f32x16 o[2] = {}; bf16x8 qr[6];
  const bfraw* Qw = Qb + (size_t)(wid * 32 + r32) * DQK + hi * 8;
#pragma unroll
  for (int d0 = 0; d0 < 6; ++d0) qr[d0] = *(const bf16x8*)(Qw + d0 * 16);
  const int sr = tid >> 3, sc = (tid & 7) * 8;
  const int sr2 = (tid & 255) >> 2, sc2 = 64 + (tid & 3) * 8;
  const bool kx = wid < 4;
  const int vst = v_st(sr, sc), kst = KSWZ(sr, sc * 2), kst2 = KSWZ(sr2, sc2 * 2);
  const int vb0 = (int)(uintptr_t)V_lds + v_rd_base(lane);
  struct { bf16x8 vs, ks, ks2; } sr_[2];
#define SLOAD(i, k0) do { sr_[i].vs = *(const bf16x8*)(Vh + (size_t)((k0) + sr) * DV + sc); sr_[i].ks = *(const bf16x8*)(Kh + (size_t)((k0) + sr) * DQK + sc); \
    if (kx) sr_[i].ks2 = *(const bf16x8*)(Kh + (size_t)((k0) + sr2) * DQK + sc2); } while (0)
#define SWRITE(b, i) do { *(bf16x8*)(V_lds + (b) * SHM_V + vst) = sr_[i].vs; *(bf16x8*)(K_lds + (b) * SHM_K + kst) = sr_[i].ks; \
    if (kx) *(bf16x8*)(K_lds + (b) * SHM_K + kst2) = sr_[i].ks2; } while (0)
#define RESC(a) do { if (__any((a) < 1.f)) { if (hi == 0) al_l[r32] = (a); asm volatile("s_waitcnt lgkmcnt(0)" ::: "memory"); \
    _Pragma("unroll") for (int d = 0; d < 2; ++d) _Pragma("unroll") for (int r = 0; r < 16; ++r) o[d][r] *= al_l[crow(r, hi)]; } } while (0)
  f32x16 pA0, pA1, pB0, pB1; float mnA, mnB, alA, alB; bf16x8 pa0, pa1, pa2, pa3; const int NT = seq / 64;
  constexpr int SE = 0, SO = 1;
  SLOAD(SE, 0); SWRITE(0, SE); __syncthreads();
  qkt(pA0, pA1, K_lds, qr, r32, hi); partialSM(pA0, pA1, m_reg, mnA, alA);
  SLOAD(SO, 64); if (2 < NT) SLOAD(SE, 128);
  SWRITE(1, SO); __syncthreads();
  for (int j = 1; j + 1 < NT; j += 2) {
    SBAR(); qkt(pB0, pB1, K_lds + SHM_K, qr, r32, hi);
    finishSM(pA0, pA1, alA, l_reg, pa0, pa1, pa2, pa3); SBAR();
    SLOAD(SO, (j + 2) * 64); SBAR();
    pv_d0(o, vb0, pa0, pa1, pa2, pa3); partialSM(pB0, pB1, m_reg, mnB, alB);
    __syncthreads(); SWRITE(0, SE);
    RESC(alB); __syncthreads();
    SBAR(); qkt(pA0, pA1, K_lds, qr, r32, hi);
    finishSM(pB0, pB1, alB, l_reg, pa0, pa1, pa2, pa3); SBAR();
    if (j + 3 < NT) SLOAD(SE, (j + 3) * 64); SBAR();
    pv_d0(o, vb0 + SHM_V, pa0, pa1, pa2, pa3); partialSM(pA0, pA1, m_reg, mnA, alA);
    __syncthreads(); SWRITE(1, SO);
    RESC(alA); __syncthreads();
  }
  SBAR(); qkt(pB0, pB1, K_lds + SHM_K, qr, r32, hi);
  finishSM(pA0, pA1, alA, l_reg, pa0, pa1, pa2, pa3); SBAR();
  pv_d0(o, vb0, pa0, pa1, pa2, pa3); partialSM(pB0, pB1, m_reg, mnB, alB);
  __syncthreads(); RESC(alB);
  finishSM(pB0, pB1, alB, l_reg, pa0, pa1, pa2, pa3); SBAR();
  pv_d0(o, vb0 + SHM_V, pa0, pa1, pa2, pa3);
  if (hi == 0) li_l[r32] = l_reg; asm volatile("s_waitcnt lgkmcnt(0)" ::: "memory");
#pragma unroll
  for (int r = 0; r < 16; ++r) {
    const int row = orow0 + wid * 32 + crow(r, hi);
    const float rli = __builtin_amdgcn_rcpf(li_l[crow(r, hi)]);
#pragma unroll
    for (int d0 = 0; d0 < 2; ++d0) {
      const int col = h * 64 + d0 * 32 + r32;
      const float g = bf2f((short)U[(size_t)row * DIN + U_GA + col]);
      Y[(size_t)row * DM + col] = f2bf(o[d0][r] * rli * silu_f(g));
    }
  }
  __syncthreads();
#undef SLOAD
#undef SWRITE
#undef RESC
}

DI void pd_attn(const Params& p, int l, char* lds) {
  const bfraw* Q = (const bfraw*)(p.ws + WS_Q); const bfraw* Kd = (const bfraw*)(p.ws + WS_K); const bfraw* Vd = (const bfraw*)(p.ws + WS_V);
  const bfraw* U = (const bfraw*)(p.ws + WS_U); bfraw* Y = (bfraw*)(p.ws + WS_H);
  const int nitem = 1024 + ((l == DEPTH - 1) ? 0 : 32);
  for (int it = blockIdx.x; it < nitem; it += gridDim.x) {
    int b, h, q0, seq, orow0;
    if (it < 1024) { b = it >> 8; h = it & 7; const int qb = (it >> 3) & 31; q0 = CLEN + qb * 256; seq = NKEY; orow0 = b * TSEQ + qb * 256; }
    else { const int c = it - 1024; b = c >> 3; h = c & 7; q0 = 0; seq = CLEN; orow0 = NLAT + b * CLEN; }
    const size_t bh = (size_t)(b * NH + h) * NKEY;
    attn_body(Q + (bh + q0) * DQK, Kd + bh * DQK, Vd + bh * DV, seq, lds, U, Y, orow0, h);
  }
}

__global__ void __launch_bounds__(NTHR) mega(Params p) {
  extern __shared__ __attribute__((aligned(16))) char lds[];
  cg::grid_group grid = cg::this_grid();
  const int lo = p.ph_lo, hi = p.ph_hi;
#define PHASE(k, call) if (lo <= (k) && (k) < hi) { if ((k) > lo) grid.sync(); call; }
  PHASE(0, p0_prologue(p, lds))
  PHASE(1, pa_norm(p, 0))
  PHASE(2, pb_inproj(p, 0, lds))
  PHASE(3, (pc_q(p, 0, lds), pc_kv(p, 0, lds), pc_conv(p, 0, lds)))
  PHASE(4, pd_attn(p, 0, lds))
  PHASE(5, pe_outproj(p, 0, lds))
  PHASE(6, pa_norm(p, 1))
  PHASE(7, pb_inproj(p, 1, lds))
  PHASE(8, (pc_q(p, 1, lds), pc_kv(p, 1, lds), pc_conv(p, 1, lds)))
  PHASE(9, pd_attn(p, 1, lds))
  PHASE(10, pe_outproj(p, 1, lds))
#undef PHASE
}

extern "C" void kernel_launch(void* const* d_in, const int* in_sizes, int n_in, void* d_out, int out_size, void* d_ws, size_t ws_size,
                              hipStream_t stream) {
  static int grid_blocks = 0;
  if (grid_blocks == 0) {
    if (n_in != 22 || out_size != NLAT * DM || ws_size < WS_END) {
      fprintf(stderr, "kernel_launch: unexpected shapes n_in %d out %d ws %zu (need %zu)\n", n_in, out_size, ws_size, (size_t)WS_END); grid_blocks = -1; return; }
    int dev = 0, cus = 0, per_cu = 0;
    hipGetDevice(&dev);
    hipDeviceGetAttribute(&cus, hipDeviceAttributeMultiprocessorCount, dev);
    if (hipFuncSetAttribute((const void*)mega, hipFuncAttributeMaxDynamicSharedMemorySize, LDS_BYTES) != hipSuccess) {
      fprintf(stderr, "kernel_launch: hipFuncSetAttribute failed\n"); grid_blocks = -1; return; }
    hipOccupancyMaxActiveBlocksPerMultiprocessor(&per_cu, (const void*)mega, NTHR, LDS_BYTES);
    if (per_cu < 1) per_cu = 1;
    grid_blocks = cus * per_cu;
    (void)hipGetLastError();
  }
  if (grid_blocks < 0) return;
  Params p{};
  const float** pp = (const float**)&p;
  for (int i = 0; i < 22; ++i) pp[i] = (const float*)d_in[i];
  p.out = (float*)d_out; p.ws = (unsigned char*)d_ws;
  constexpr int NPH = 1 + 5 * DEPTH;
#if ONE_LAUNCH
  p.ph_lo = 0; p.ph_hi = NPH;
  void* args[] = {&p};
  hipError_t e = hipLaunchCooperativeKernel((const void*)mega, dim3(grid_blocks), dim3(NTHR), args, LDS_BYTES, stream);
  if (e != hipSuccess) fprintf(stderr, "cooperative launch failed: %s (grid %d)\n", hipGetErrorString(e), grid_blocks);
#else
  for (int ph = 0; ph < NPH; ++ph) {
    p.ph_lo = ph; p.ph_hi = ph + 1;
    hipLaunchKernelGGL(mega, dim3(grid_blocks), dim3(NTHR), LDS_BYTES, stream, p);
  }
#endif
}
```

```cpp
#include <hip/hip_runtime.h>
#include <hip/hip_bf16.h>
#include <hip/hip_cooperative_groups.h>
#include <cstdio>
#include <cstdint>
namespace cg = cooperative_groups;

#ifndef ONE_LAUNCH
#define ONE_LAUNCH 1
#endif

constexpr int DM = 1024, NBATCH = 4, TSEQ = 8192, CLEN = 256, DEPTH = 2;
constexpr int NLAT = NBATCH * TSEQ;
constexpr int NCTX = NBATCH * CLEN;
constexpr int NTOK = NLAT + NCTX;
constexpr int DIN = 2720, DINP = 2816;
constexpr int NH = 8, DQK = 96, DV = 64, NKEY = CLEN + TSEQ;
constexpr int U_CQ = 0, U_CKV = 256, U_KR = 384, U_GA = 416, U_SCIN = 928, U_SCB = 1184, U_SCC = 1440, U_GB = 1696,
              U_CFA = 1952, U_CFG = 2208, U_GC = 2464;
constexpr float EPS = 1e-6f, LN_EPS = 1e-5f;
constexpr float QSCALE = 0.10206207261596575f * 1.4426950408889634f;
constexpr int NTHR = 512;

constexpr size_t AL(size_t x) { return (x + 255) / 256 * 256; }
constexpr size_t WS_WIN  = 0;
constexpr size_t WS_WUQ  = WS_WIN  + AL((size_t)DEPTH * DINP * DM * 2);
constexpr size_t WS_WUKV = WS_WUQ  + AL((size_t)DEPTH * 768 * 256 * 2);
constexpr size_t WS_WPW  = WS_WUKV + AL((size_t)DEPTH * 1024 * 128 * 2);
constexpr size_t WS_WOUT = WS_WPW  + AL((size_t)DEPTH * 256 * 256 * 2);
constexpr size_t WS_MOD  = WS_WOUT + AL((size_t)DEPTH * DM * DM * 2);
constexpr size_t WS_H    = WS_MOD  + AL((size_t)DEPTH * 5 * 3072 * 4);
constexpr size_t WS_U    = WS_H    + AL((size_t)NTOK * DM * 2);
constexpr size_t WS_Q    = WS_U    + AL((size_t)NTOK * DIN * 2);
constexpr size_t WS_K    = WS_Q    + AL((size_t)NBATCH * NH * NKEY * DQK * 2);
constexpr size_t WS_V    = WS_K    + AL((size_t)NBATCH * NH * NKEY * DQK * 2);
constexpr size_t WS_XC1  = WS_V    + AL((size_t)NBATCH * NH * NKEY * DV * 2);
constexpr size_t WS_BAR  = WS_XC1  + AL((size_t)NCTX * DM * 4);
constexpr size_t WS_END  = WS_BAR  + AL((size_t)4096 * 4);

constexpr int LDS_PHASE_BYTES = 144 * 1024, LDS_BYTES = LDS_PHASE_BYTES + 16;

using bf16x8 = __attribute__((ext_vector_type(8))) short;
using s16x4  = __attribute__((ext_vector_type(4))) short;
using f32x4  = __attribute__((ext_vector_type(4))) float;
using f32x16 = __attribute__((ext_vector_type(16))) float;
using u32x4  = __attribute__((ext_vector_type(4))) unsigned;
using u32x2  = __attribute__((ext_vector_type(2))) unsigned;
typedef unsigned short bfraw;
#define DI __device__ __forceinline__
#define SBAR() __builtin_amdgcn_sched_barrier(0)

DI int tid_opaque() { int t = __builtin_amdgcn_workitem_id_x(); asm volatile("" : "+v"(t)); return t; }
#define TIDX() tid_opaque()
DI float bf2f(short s) { return __uint_as_float(((unsigned)(unsigned short)s) << 16); }
DI bfraw f2bf(float x) { unsigned u = __float_as_uint(x); u += 0x7fffu + ((u >> 16) & 1u); return (bfraw)(u >> 16); }
DI unsigned cvtpk(float lo, float hi) { unsigned r; asm("v_cvt_pk_bf16_f32 %0, %1, %2" : "=v"(r) : "v"(lo), "v"(hi)); return r; }
DI u32x2 pack4(float a, float b, float c, float d) { u32x2 r = {cvtpk(a, b), cvtpk(c, d)}; return r; }
DI float silu_f(float x) { return x * __builtin_amdgcn_rcpf(1.f + __expf(-x)); }
DI float sigmoid_f(float x) { return __builtin_amdgcn_rcpf(1.f + __expf(-x)); }
DI f32x4 mfma16(bf16x8 a, bf16x8 b, f32x4 c) { return __builtin_amdgcn_mfma_f32_16x16x32_bf16(a, b, c, 0, 0, 0); }

struct Params {
  const float* x; const float* c; const float* ctx; const float* c_ctx; const float* norm_w; const float* w_mod; const float* b_mod;
  const float* w_in; const float* q_norm_w; const float* w_uq; const float* kv_norm_w; const float* w_ukv; const float* q_head_norm_w;
  const float* k_head_norm_w; const float* sc_conv_w; const float* cf_conv_w; const float* cf_conv_b; const float* cf_ln_w;
  const float* cf_ln_b; const float* cf_pw_w; const float* cf_pw_b; const float* w_out;
  float* out; unsigned char* ws; int ph_lo, ph_hi;
};

DI void row_info(int row, int& b, bool& lat, int& pos) {
  if (row < NLAT) { lat = true; b = row >> 13; pos = row & (TSEQ - 1); }
  else { int c = row - NLAT; lat = false; b = c >> 8; pos = c & (CLEN - 1); }
}

struct TrJob { const float* src; bfraw* dst; const float* scale; int K, N, k0, n0; };
DI TrJob tr_decode(const Params& p, int it) {
  constexpr int PER_L = 1056;
  const int l = it / PER_L, r = it % PER_L; TrJob j;
  if (r < 704) { int kt = r / 44, nt = r % 44; j = TrJob{p.w_in + (size_t)l * DM * DIN, (bfraw*)(p.ws + WS_WIN) + (size_t)l * DINP * DM, nullptr, DM, DIN, kt * 64, nt * 64}; }
  else if (r < 752) { int rr = r - 704, kt = rr / 12, nt = rr % 12; j = TrJob{p.w_uq + (size_t)l * 256 * 768, (bfraw*)(p.ws + WS_WUQ) + (size_t)l * 768 * 256, p.q_norm_w + l * 256, 256, 768, kt * 64, nt * 64}; }
  else if (r < 784) { int rr = r - 752, kt = rr / 16, nt = rr % 16; j = TrJob{p.w_ukv + (size_t)l * 128 * 1024, (bfraw*)(p.ws + WS_WUKV) + (size_t)l * 1024 * 128, p.kv_norm_w + l * 128, 128, 1024, kt * 64, nt * 64}; }
  else if (r < 800) { int rr = r - 784, kt = rr / 4, nt = rr % 4; j = TrJob{p.cf_pw_w + (size_t)l * 256 * 256, (bfraw*)(p.ws + WS_WPW) + (size_t)l * 256 * 256, nullptr, 256, 256, kt * 64, nt * 64}; }
  else { int rr = r - 800, kt = rr / 16, nt = rr % 16; j = TrJob{p.w_out + (size_t)l * DM * DM, (bfraw*)(p.ws + WS_WOUT) + (size_t)l * DM * DM, nullptr, DM, DM, kt * 64, nt * 64}; }
  return j;
}
DI void tr_load(const TrJob& j, f32x4 (&v)[2]) {
  const int tid = TIDX();
#pragma unroll
  for (int i = 0; i < 2; ++i) {
    const int r = (tid >> 4) + i * 32, c = (tid & 15) * 4, n = j.n0 + c;
    v[i] = f32x4{0.f, 0.f, 0.f, 0.f};
    if (n < j.N) v[i] = *(const f32x4*)(j.src + (size_t)(j.k0 + r) * j.N + n);
    if (j.scale) { const float s = j.scale[j.k0 + r]; v[i] *= s; }
  }
}
DI void tr_lds(const f32x4 (&v)[2], float* tile) {
  const int tid = TIDX();
#pragma unroll
  for (int i = 0; i < 2; ++i) { const int r = (tid >> 4) + i * 32, c = (tid & 15) * 4; float* tp = tile + r * 65 + c; tp[0] = v[i][0]; tp[1] = v[i][1]; tp[2] = v[i][2]; tp[3] = v[i][3]; }
}
DI void tr_store(const TrJob& j, const float* tile) {
  const int tid = TIDX(), n = tid >> 3, k8 = (tid & 7) * 8;
  const float* tp = tile + k8 * 65 + n;
  u32x4 w = {cvtpk(tp[0], tp[65]), cvtpk(tp[130], tp[195]), cvtpk(tp[260], tp[325]), cvtpk(tp[390], tp[455])};
  *(u32x4*)(j.dst + (size_t)(j.n0 + n) * j.K + j.k0 + k8) = w;
}

DI void p0_prologue(const Params& p, char* lds) {
  const int tid = TIDX();
  constexpr int PER_L = 1056, NTR = DEPTH * PER_L, NMOD = DEPTH * 96;
  constexpr int TS = 64 * 65;
  const int G = gridDim.x;
  for (int it0 = blockIdx.x; it0 < NTR; it0 += 4 * G) {
    TrJob j0 = tr_decode(p, it0), j1 = j0, j2 = j0, j3 = j0;
    const bool h1 = it0 + G < NTR, h2 = it0 + 2 * G < NTR, h3 = it0 + 3 * G < NTR;
    if (h1) j1 = tr_decode(p, it0 + G); if (h2) j2 = tr_decode(p, it0 + 2 * G); if (h3) j3 = tr_decode(p, it0 + 3 * G);
    f32x4 v0[2], v1[2], v2[2], v3[2];
    tr_load(j0, v0); if (h1) tr_load(j1, v1); if (h2) tr_load(j2, v2); if (h3) tr_load(j3, v3);
    float* tile = (float*)lds;
    tr_lds(v0, tile); if (h1) tr_lds(v1, tile + TS); if (h2) tr_lds(v2, tile + 2 * TS); if (h3) tr_lds(v3, tile + 3 * TS);
    __syncthreads();
    tr_store(j0, tile); if (h1) tr_store(j1, tile + TS); if (h2) tr_store(j2, tile + 2 * TS); if (h3) tr_store(j3, tile + 3 * TS);
    __syncthreads();
  }
  for (int it = NTR + (int)((blockIdx.x + 64) % gridDim.x); it < NTR + NMOD; it += gridDim.x) {
    {
      const int m = it - NTR, l = m / 96, j0 = (m % 96) * 32;
      float* sl = (float*)lds;
      float* red = sl + 5 * 1024;
      for (int idx = tid; idx < 5 * 1024; idx += NTHR) {
        int r = idx >> 10, k = idx & 1023; float v = (r < 4) ? p.c[r * 1024 + k] : p.c_ctx[k]; sl[idx] = silu_f(v);
      }
      __syncthreads();
      const int col = tid & 31, kg = tid >> 5;
      float a0 = 0, a1 = 0, a2 = 0, a3 = 0, a4 = 0;
      const float* wm = p.w_mod + ((size_t)l * 1024 + kg * 64) * 3072 + j0 + col;
#pragma unroll 16
      for (int kk = 0; kk < 64; ++kk) {
        float w = wm[(size_t)kk * 3072]; int k = kg * 64 + kk;
        a0 += sl[k] * w; a1 += sl[1024 + k] * w; a2 += sl[2048 + k] * w; a3 += sl[3072 + k] * w; a4 += sl[4096 + k] * w;
      }
      red[(kg * 5 + 0) * 32 + col] = a0; red[(kg * 5 + 1) * 32 + col] = a1; red[(kg * 5 + 2) * 32 + col] = a2;
      red[(kg * 5 + 3) * 32 + col] = a3; red[(kg * 5 + 4) * 32 + col] = a4;
      __syncthreads();
      if (tid < 160) {
        int r = tid >> 5, cc = tid & 31; float s = p.b_mod[l * 3072 + j0 + cc];
        for (int g = 0; g < 16; ++g) s += red[(g * 5 + r) * 32 + cc];
        ((float*)(p.ws + WS_MOD))[(l * 5 + r) * 3072 + j0 + cc] = s;
      }
      __syncthreads();
    }
  }
}

DI void pa_norm(const Params& p, int l) {
  const int lane = TIDX() & 63, wid = TIDX() >> 6;
  const float* xl = (l == 0) ? p.x : p.out;
  const float* xc = (l == 0) ? p.ctx : (const float*)(p.ws + WS_XC1);
  const float* mod = (const float*)(p.ws + WS_MOD) + (size_t)l * 5 * 3072;
  const float* nw = p.norm_w + l * DM;
  bfraw* H = (bfraw*)(p.ws + WS_H);
  for (int row = blockIdx.x * 8 + wid; row < NTOK; row += gridDim.x * 8) {
    int b, pos; bool lat; row_info(row, b, lat, pos);
    const float* src = lat ? xl + (size_t)row * DM : xc + (size_t)(row - NLAT) * DM;
    const float* mr = mod + (lat ? b : 4) * 3072;
    f32x4 v[4]; float ss = 0.f;
#pragma unroll
    for (int i = 0; i < 4; ++i) { v[i] = *(const f32x4*)(src + i * 256 + lane * 4); ss += v[i][0] * v[i][0] + v[i][1] * v[i][1] + v[i][2] * v[i][2] + v[i][3] * v[i][3]; }
#pragma unroll
    for (int o = 32; o >= 1; o >>= 1) ss += __shfl_xor(ss, o);
    const float r = rsqrtf(ss * (1.f / DM) + EPS);
#pragma unroll
    for (int i = 0; i < 4; ++i) {
      const int k = i * 256 + lane * 4;
      f32x4 w = *(const f32x4*)(nw + k), sh = *(const f32x4*)(mr + k), sc = *(const f32x4*)(mr + 1024 + k);
      float h0 = v[i][0] * r * w[0] * (1.f + sc[0]) + sh[0], h1 = v[i][1] * r * w[1] * (1.f + sc[1]) + sh[1];
      float h2 = v[i][2] * r * w[2] * (1.f + sc[2]) + sh[2], h3 = v[i][3] * r * w[3] * (1.f + sc[3]) + sh[3];
      *(u32x2*)(H + (size_t)row * DM + k) = pack4(h0, h1, h2, h3);
    }
  }
}

constexpr int G_PITCH = 144, G_ABYTES = 128 * G_PITCH, G_BBYTES = 256 * G_PITCH, G_STAGE = G_ABYTES + G_BBYTES;
template <class Epi>
DI void gemm_tile(const bfraw* __restrict__ A, int lda, const bfraw* __restrict__ Bt, int ldb, int K, int m0, int n0, char* lds, Epi epi) {
  const int tid = TIDX(), lane = tid & 63, wid = tid >> 6, wm = wid >> 2, wn = wid & 3, l15 = lane & 15, quad = lane >> 4;
  f32x4 acc[4][4];
#pragma unroll
  for (int i = 0; i < 4; ++i)
#pragma unroll
    for (int j = 0; j < 4; ++j) acc[i][j] = f32x4{0.f, 0.f, 0.f, 0.f};
  const int srow = tid >> 3, skc = tid & 7;
  const bfraw* Ag = A + (size_t)(m0 + srow) * lda + skc * 8;
  const bfraw* Bg = Bt + (size_t)(n0 + srow) * ldb + skc * 8;
  bf16x8 ra0, ra1, rb0, rb1, rb2, rb3;
#define GLOAD(k0) do { ra0 = *(const bf16x8*)(Ag + (k0)); ra1 = *(const bf16x8*)(Ag + (size_t)64 * lda + (k0)); \
    rb0 = *(const bf16x8*)(Bg + (k0)); rb1 = *(const bf16x8*)(Bg + (size_t)64 * ldb + (k0)); \
    rb2 = *(const bf16x8*)(Bg + (size_t)128 * ldb + (k0)); rb3 = *(const bf16x8*)(Bg + (size_t)192 * ldb + (k0)); } while (0)
#define SWRITE(s) do { char* _b = lds + (s) * G_STAGE + srow * G_PITCH + skc * 16; \
    *(bf16x8*)(_b) = ra0; *(bf16x8*)(_b + 64 * G_PITCH) = ra1; \
    *(bf16x8*)(_b + G_ABYTES) = rb0; *(bf16x8*)(_b + G_ABYTES + 64 * G_PITCH) = rb1; \
    *(bf16x8*)(_b + G_ABYTES + 128 * G_PITCH) = rb2; *(bf16x8*)(_b + G_ABYTES + 192 * G_PITCH) = rb3; } while (0)
  GLOAD(0); SWRITE(0); __syncthreads();
  const int nk = K >> 6;
  for (int kt = 0; kt < nk; ++kt) {
    if (kt + 1 < nk) GLOAD((kt + 1) * 64);
    const char* base = lds + (kt & 1) * G_STAGE;
    const char* ap = base + (wm * 64 + l15) * G_PITCH + quad * 16;
    const char* bp = base + G_ABYTES + (wn * 64 + l15) * G_PITCH + quad * 16;
#pragma unroll
    for (int ks = 0; ks < 2; ++ks) {
      bf16x8 af[4], bfr[4];
#pragma unroll
      for (int mi = 0; mi < 4; ++mi) af[mi] = *(const bf16x8*)(ap + mi * 16 * G_PITCH + ks * 64);
#pragma unroll
      for (int ni = 0; ni < 4; ++ni) bfr[ni] = *(const bf16x8*)(bp + ni * 16 * G_PITCH + ks * 64);
#pragma unroll
      for (int ni = 0; ni < 4; ++ni)
#pragma unroll
        for (int mi = 0; mi < 4; ++mi) acc[ni][mi] = mfma16(bfr[ni], af[mi], acc[ni][mi]);
    }
    if (kt + 1 < nk) SWRITE((kt + 1) & 1);
    __syncthreads();
  }
#undef GLOAD
#undef SWRITE
#pragma unroll
  for (int ni = 0; ni < 4; ++ni)
#pragma unroll
    for (int mi = 0; mi < 4; ++mi) epi(m0 + wm * 64 + mi * 16 + l15, n0 + wn * 64 + ni * 16 + quad * 4, acc[ni][mi]);
}

#include <hip/hip_runtime.h>
namespace pg8 {
#define PG8_LAS __attribute__((address_space(3)))
typedef unsigned short bf16_t;
typedef short bf16x8 __attribute__((ext_vector_type(8)));
typedef float f32x4 __attribute__((ext_vector_type(4)));
typedef unsigned u32x4 __attribute__((ext_vector_type(4)));
constexpr int BM = 256, BK = 64, HALF = 128, HTB = HALF * BK * 2  , STAGE_BYTES = 8 * HTB, NXCD = 8, WGM = 8;

__host__ __device__ __forceinline__ int lds_byte(int r, int c) { const int st = (r >> 4) * 2 + (c >> 5), rr = r & 15, cc = c & 31, ob = rr * 64 + cc * 2; return st * 1024 + (ob ^ (((ob >> 9) & 1) << 5)); }
__host__ __device__ __forceinline__ void stage_rc(int b, int& R, int& C) { const int st = b / 1024, sb = b % 1024, swz = sb ^ (((sb >> 9) & 1) << 5); R = (st >> 1) * 16 + swz / 64; C = (st & 1) * 32 + (swz % 64) / 2; }
__host__ __device__ __forceinline__ int perm32(int rho) { const int n = rho >> 4, i = rho & 15; return 8 * (i >> 2) + 4 * n + (i & 3); }

struct Unit { int pm, pn; };
struct Gemm { const bf16_t* A; const bf16_t* Bt; int M, N, K; };

struct StaticOrder {
    int nM, nN, nwg, G, c;
    __host__ __device__ void init(int M, int N, int G_, int c_) { nM = M / BM; nN = N / BM; nwg = nM * nN; G = G_; c = c_; }
    __host__ __device__ bool next(int i, Unit& u) const {
        const long L = (long)i * G + c; if (L >= nwg) return false;
        int wgid = (int)L; { const int q = nwg / NXCD, r = nwg % NXCD, xcd = wgid % NXCD, off = wgid / NXCD; wgid = (xcd < r ? xcd * (q + 1) : r * (q + 1) + (xcd - r) * q) + off; }
        const int nig = WGM * nN, gid = wgid / nig, fm = gid * WGM, gsz = (nM - fm) < WGM ? (nM - fm) : WGM;
        u.pm = fm + ((wgid % nig) % gsz); u.pn = (wgid % nig) / gsz; return true;
    }
    __device__ __forceinline__ void a_ready(const Unit&) const {}
    __device__ __forceinline__ void done(const Unit&) const {}
};
template <class Epi, class Sched, bool STAMP = false>
__device__ __forceinline__ void gemm_phase(PG8_LAS unsigned char* lds, const Gemm g, const Sched& S, const Epi& E, unsigned long long* stamps) {
    const int tid = TIDX(), wid = __builtin_amdgcn_readfirstlane(tid >> 6), lane = tid & 63, wr = wid >> 2, wc = wid & 3, fr = lane & 15, fq = lane >> 4;
    const int K = g.K, nt = K / BK;
    int ts_lo = 0, ts_hi = 0, nts = 0; const unsigned long long rt_entry = STAMP ? (unsigned long long)wall_clock64() : 0ull;
#define PG8_STAMP() do { if (STAMP && wid == 0 && nts < 64) { const unsigned long long _c = (unsigned long long)clock64(); \
        ts_lo = (lane == nts) ? (int)(unsigned)_c : ts_lo; ts_hi = (lane == nts) ? (int)(unsigned)(_c >> 32) : ts_hi; ++nts; } } while (0)
    PG8_STAMP();
    unsigned voffA[2], voffB[2];
#pragma unroll
    for (int i = 0; i < 2; ++i) { int R, C; stage_rc(tid * 16 + i * 8192, R, C); const int Rb = Epi::PERM ? ((R & ~31) + perm32(R & 31)) : R;
        voffA[i] = (unsigned)(R * K + C) * 2u; voffB[i] = (unsigned)(Rb * K + C) * 2u; }
    const size_t kstep = (size_t)(BK * 2);
    const size_t hstep = (size_t)HALF * K * 2;
    const size_t tstep = 2 * hstep;
    const unsigned ldsw = (unsigned)wid * 1024u;
    const int aoff = lds_byte(wr * 64 + fr, fq * 8), boff = lds_byte(wc * 32 + fr, fq * 8);
#define PG8_SA(b, h) (((b) * 2 + (h)) * HTB)
#define PG8_SB(b, h) ((4 + (b) * 2 + (h)) * HTB)
#define PG8_STAGE(bufoff, gbase, voff) do { _Pragma("unroll") for (int _i = 0; _i < 2; ++_i) \
        __builtin_amdgcn_global_load_lds((const unsigned*)((const char*)(gbase) + (voff)[_i]), (PG8_LAS unsigned*)(lds + (bufoff) + ldsw + _i * 8192), 16, 0, 0); } while (0)
#define PG8_LDA(dst, b, h) do { _Pragma("unroll") for (int m = 0; m < 4; ++m) _Pragma("unroll") for (int k = 0; k < 2; ++k) dst[m][k] = *(const PG8_LAS bf16x8*)(lds + PG8_SA(b, h) + aoff + m * 2048 + k * 1024); } while (0)
#define PG8_LDB(dst, b, h) do { _Pragma("unroll") for (int n = 0; n < 2; ++n) _Pragma("unroll") for (int k = 0; k < 2; ++k) dst[n][k] = *(const PG8_LAS bf16x8*)(lds + PG8_SB(b, h) + boff + n * 2048 + k * 1024); } while (0)
#define PG8_MMA(ai, bj, At, Bt) do { __builtin_amdgcn_s_setprio(1); _Pragma("unroll") for (int m = 0; m < 4; ++m) _Pragma("unroll") for (int n = 0; n < 2; ++n) _Pragma("unroll") for (int k = 0; k < 2; ++k) \
        acc[ai][bj][m][n] = __builtin_amdgcn_mfma_f32_16x16x32_bf16(Bt[n][k], At[m][k], acc[ai][bj][m][n], 0, 0, 0); __builtin_amdgcn_s_setprio(0); } while (0)
#define PG8_WAIT_V(n) asm volatile("s_waitcnt vmcnt(" #n ")" ::: "memory")
#define PG8_WAIT_L(n) asm volatile("s_waitcnt lgkmcnt(" #n ")" ::: "memory")
#define PG8_BAR __builtin_amdgcn_s_barrier()
#define PG8_SCHED __builtin_amdgcn_sched_barrier(0)
    Unit cur, nxt; int ui = 0;
    if (!S.next(0, cur)) return;
    f32x4 acc[2][2][4][2];
#pragma unroll
    for (int a = 0; a < 2; ++a)
#pragma unroll
        for (int b = 0; b < 2; ++b)
#pragma unroll
            for (int m = 0; m < 4; ++m)
#pragma unroll
                for (int n = 0; n < 2; ++n) acc[a][b][m][n] = (f32x4){0.f, 0.f, 0.f, 0.f};
    bf16x8 At[4][2], B0[2][2], B1[2][2];
    const char* cA = (const char*)g.A + (size_t)cur.pm * tstep; const char* cB = (const char*)g.Bt + (size_t)cur.pn * tstep;
    S.a_ready(cur);
    PG8_STAGE(PG8_SB(0, 0), cB, voffB); PG8_STAGE(PG8_SA(0, 0), cA, voffA); PG8_STAGE(PG8_SB(0, 1), cB + hstep, voffB); PG8_STAGE(PG8_SA(0, 1), cA + hstep, voffA);
    if (wr == 1) PG8_BAR;
    PG8_WAIT_V(4); PG8_BAR;
    PG8_STAGE(PG8_SB(1, 0), cB + kstep, voffB); PG8_STAGE(PG8_SA(1, 0), cA + kstep, voffA); PG8_STAGE(PG8_SB(1, 1), cB + hstep + kstep, voffB);
    PG8_WAIT_V(6); PG8_BAR;
    PG8_STAMP();
    for (;;) {
        const bool has_next = S.next(ui + 1, nxt);
        const char* nA = has_next ? (const char*)g.A + (size_t)nxt.pm * tstep : cA; const char* nB = has_next ? (const char*)g.Bt + (size_t)nxt.pn * tstep : cB;
        for (int t = 0; t < nt; t += 2) {
            const bool last = (t == nt - 2);
            const char* a1 = cA + (size_t)(t + 1) * kstep;
            const char* a2 = last ? nA : cA + (size_t)(t + 2) * kstep; const char* b2 = last ? nB : cB + (size_t)(t + 2) * kstep;
            const char* a3 = a2 + kstep; const char* b3 = b2 + kstep;
            if (last && has_next) S.a_ready(nxt);
            PG8_LDB(B0, 0, 0); PG8_SCHED; PG8_LDA(At, 0, 0); PG8_STAGE(PG8_SA(1, 1), a1 + hstep, voffA);
            PG8_WAIT_L(8); PG8_BAR; PG8_WAIT_L(0); PG8_MMA(0, 0, At, B0); PG8_BAR; PG8_SCHED;
            PG8_LDB(B1, 0, 1); PG8_STAGE(PG8_SB(0, 0), b2, voffB);
            PG8_BAR; PG8_WAIT_L(0); PG8_MMA(0, 1, At, B1); PG8_BAR;
            PG8_LDA(At, 0, 1); PG8_STAGE(PG8_SA(0, 0), a2, voffA);
            PG8_BAR; PG8_WAIT_L(0); PG8_MMA(1, 0, At, B0); PG8_BAR; PG8_SCHED;
            PG8_STAGE(PG8_SB(0, 1), b2 + hstep, voffB);
            PG8_WAIT_V(6); PG8_BAR; PG8_MMA(1, 1, At, B1); PG8_BAR;
            PG8_LDB(B0, 1, 0); PG8_SCHED; PG8_LDA(At, 1, 0); PG8_STAGE(PG8_SA(0, 1), a2 + hstep, voffA);
            PG8_WAIT_L(8); PG8_BAR; PG8_WAIT_L(0); PG8_MMA(0, 0, At, B0); PG8_BAR; PG8_SCHED;
            PG8_LDB(B1, 1, 1); PG8_STAGE(PG8_SB(1, 0), b3, voffB);
            PG8_BAR; PG8_WAIT_L(0); PG8_MMA(0, 1, At, B1); PG8_BAR;
            PG8_LDA(At, 1, 1); PG8_STAGE(PG8_SA(1, 0), a3, voffA);
            PG8_BAR; PG8_WAIT_L(0); PG8_MMA(1, 0, At, B0); PG8_BAR; PG8_SCHED;
            PG8_STAGE(PG8_SB(1, 1), b3 + hstep, voffB);
            PG8_WAIT_V(6); PG8_BAR; PG8_MMA(1, 1, At, B1); PG8_BAR;
        }
        PG8_STAMP();
        if constexpr (!Epi::AFTER_DRAIN) { E(acc, cur, wr, wc, fr, fq); S.done(cur); }
        PG8_STAMP();
        if (!has_next) break;
#pragma unroll
        for (int a = 0; a < 2; ++a)
#pragma unroll
            for (int b = 0; b < 2; ++b)
#pragma unroll
                for (int m = 0; m < 4; ++m)
#pragma unroll
                    for (int n = 0; n < 2; ++n) acc[a][b][m][n] = (f32x4){0.f, 0.f, 0.f, 0.f};
        cur = nxt; cA = nA; cB = nB; ++ui;
    }
    PG8_WAIT_V(0);
    if (wr == 0) PG8_BAR;
    PG8_BAR;
    if constexpr (Epi::AFTER_DRAIN) { E.fused(acc, cur, wr, wc, fr, fq, lds, wid, lane); S.done(cur); }
    PG8_STAMP();
    if (STAMP && wid == 0) { stamps[lane] = lane < nts ? (((unsigned long long)(unsigned)ts_hi << 32) | (unsigned)ts_lo) : 0ull;
        if (lane == 62) stamps[62] = rt_entry; if (lane == 63) stamps[63] = (unsigned long long)wall_clock64(); }
#undef PG8_STAMP
#undef PG8_SA
#undef PG8_SB
#undef PG8_STAGE
#undef PG8_LDA
#undef PG8_LDB
#undef PG8_MMA
#undef PG8_WAIT_V
#undef PG8_WAIT_L
#undef PG8_BAR
#undef PG8_SCHED
}
}

struct EpiU {
  static constexpr bool PERM = true, AFTER_DRAIN = false;
  bfraw* U;
  __device__ __forceinline__ void operator()(const pg8::f32x4 (&acc)[2][2][4][2], const pg8::Unit& u, int wr, int wc, int fr, int fq) const {
    const int row0 = u.pm * 256 + wr * 64 + fr, col0 = u.pn * 256 + wc * 32 + 8 * fq;
#pragma unroll
    for (int ai = 0; ai < 2; ++ai)
#pragma unroll
      for (int m = 0; m < 4; ++m) { bfraw* rowp = U + (size_t)(row0 + ai * 128 + m * 16) * DIN + col0;
#pragma unroll
        for (int bj = 0; bj < 2; ++bj) { if (col0 + bj * 128 < DIN) { const pg8::f32x4 v0 = acc[ai][bj][m][0], v1 = acc[ai][bj][m][1];
          u32x4 w = {cvtpk(v0[0], v0[1]), cvtpk(v0[2], v0[3]), cvtpk(v1[0], v1[1]), cvtpk(v1[2], v1[3])};
          *(u32x4*)(rowp + bj * 128) = w; } } }
  }
};
struct EpiRes {
  static constexpr bool PERM = false, AFTER_DRAIN = false;
  const float* xres; float* out; const float* gate;
  __device__ __forceinline__ void operator()(const pg8::f32x4 (&acc)[2][2][4][2], const pg8::Unit& u, int wr, int wc, int fr, int fq) const {
    const int row0 = u.pm * 256 + wr * 64 + fr, col0 = u.pn * 256 + wc * 32 + 4 * fq;
    const float* g = gate + (size_t)((u.pm * 256) >> 13) * 3072 + col0;
    pg8::f32x4 gv[2][2];
#pragma unroll
    for (int bj = 0; bj < 2; ++bj)
#pragma unroll
      for (int n = 0; n < 2; ++n) gv[bj][n] = *(const pg8::f32x4*)(g + bj * 128 + n * 16);
#pragma unroll
    for (int ai = 0; ai < 2; ++ai)
#pragma unroll
      for (int m = 0; m < 4; ++m) { const size_t ro = (size_t)(row0 + ai * 128 + m * 16) * DM + col0;
#pragma unroll
        for (int bj = 0; bj < 2; ++bj)
#pragma unroll
          for (int n = 0; n < 2; ++n) { const pg8::f32x4 xr = *(const pg8::f32x4*)(xres + ro + bj * 128 + n * 16);
            *(pg8::f32x4*)(out + ro + bj * 128 + n * 16) = xr + gv[bj][n] * acc[ai][bj][m][n]; } }
  }
};

DI void pb_inproj(const Params& p, int l, char* lds) {
  pg8::Gemm g{(const bfraw*)(p.ws + WS_H), (const bfraw*)(p.ws + WS_WIN) + (size_t)l * DINP * DM, NTOK, DINP, DM};
  pg8::StaticOrder S; S.init(NTOK, DINP, (int)gridDim.x, (int)blockIdx.x);
  EpiU E{(bfraw*)(p.ws + WS_U)};
  pg8::gemm_phase<EpiU, pg8::StaticOrder, false>((PG8_LAS unsigned char*)lds, g, S, E, nullptr);
}

DI void pe_outproj(const Params& p, int l, char* lds) {
  const bfraw* Y = (const bfraw*)(p.ws + WS_H);
  const bfraw* W = (const bfraw*)(p.ws + WS_WOUT) + (size_t)l * DM * DM;
  const float* mod = (const float*)(p.ws + WS_MOD) + (size_t)l * 5 * 3072 + 2048;
  {
    pg8::Gemm g{Y, W, NLAT, DM, DM};
    pg8::StaticOrder S; S.init(NLAT, DM, (int)gridDim.x, (int)blockIdx.x);
    EpiRes E{(l == 0) ? p.x : p.out, p.out, mod};
    pg8::gemm_phase<EpiRes, pg8::StaticOrder, false>((PG8_LAS unsigned char*)lds, g, S, E, nullptr);
  }
  if (l < DEPTH - 1) {
    const float* xc = p.ctx; float* oc = (float*)(p.ws + WS_XC1);
    constexpr int NT = (NCTX / 128) * 4;
    for (int t = (int)gridDim.x - 1 - (int)blockIdx.x; t < NT; t += gridDim.x) {
      const int mt = t >> 2, nt = t & 3;
      gemm_tile(Y, DM, W, DM, DM, NLAT + mt * 128, nt * 256, lds, [&](int m, int n, f32x4 v) {
        const f32x4 gg = *(const f32x4*)(mod + 4 * 3072 + n);
        const size_t o = (size_t)(m - NLAT) * DM + n;
        const f32x4 xr = *(const f32x4*)(xc + o);
        *(f32x4*)(oc + o) = xr + gg * v;
      });
    }
  }
}

DI void rows_rms(const char* tile, int pitchB, int nchunk_per_lane, float inv_n, float* out) {
  const int lane = TIDX() & 63, wid = TIDX() >> 6;
  const int row = wid * 8 + (lane >> 3), part = lane & 7;
  float ss = 0.f;
  for (int i = 0; i < nchunk_per_lane; ++i) {
    bf16x8 v = *(const bf16x8*)(tile + row * pitchB + (part + i * 8) * 16);
#pragma unroll
    for (int j = 0; j < 8; ++j) { float f = bf2f(v[j]); ss += f * f; }
  }
  ss += __shfl_xor(ss, 4); ss += __shfl_xor(ss, 2); ss += __shfl_xor(ss, 1);
  if (part == 0) out[row] = rsqrtf(ss * inv_n + EPS);
}

DI void rope_cs(int pos, int d, float& c, float& s) {
  const float pp = (float)((d < 8) ? (pos >> 6) : (pos & 63));
  const float inv = exp2f(-(float)(d & 7) * 1.6609640474436813f);
  const float ang = pp * inv;
  c = __cosf(ang); s = __sinf(ang);
}

template <int NC> DI void wave_tile_flush(const char* st, bfraw* gdst) {
  const int lane = TIDX() & 63;
  constexpr int CPR = NC / 8, NCH = 64 * CPR, PITCH = NC * 2 + 16;
  asm volatile("s_waitcnt lgkmcnt(0)" ::: "memory");
#pragma unroll
  for (int c = lane; c < NCH; c += 64) { const int row = c / CPR, cc = c % CPR;
    *(bf16x8*)(gdst + (size_t)c * 8) = *(const bf16x8*)(st + row * PITCH + cc * 16); }
  asm volatile("s_waitcnt lgkmcnt(0)" ::: "memory");
}
DI void pc_q(const Params& p, int l, char* lds) {
  const int tid = TIDX(), lane = tid & 63, h = tid >> 6, l15 = lane & 15, quad = lane >> 4;
  constexpr int PB_ = 528;
  char* At = lds; float* rq = (float*)(lds + 64 * PB_);
  char* stq = lds + 35 * 1024 + h * (64 * 208);
  const bfraw* U = (const bfraw*)(p.ws + WS_U);
  const bfraw* W = (const bfraw*)(p.ws + WS_WUQ) + (size_t)l * 768 * 256;
  bfraw* Q = (bfraw*)(p.ws + WS_Q);
  const float* wh = p.q_head_norm_w + l * DQK;
  const int ntile = ((l == DEPTH - 1) ? NLAT : NTOK) / 64;
  const bfraw* Wp = W + (size_t)(h * 96 + l15) * 256 + quad * 8;
  for (int t = blockIdx.x; t < ntile; t += gridDim.x) {
    const int m0 = t * 64;
    const bfraw* Wpt = Wp; asm volatile("" : "+v"(Wpt));
    bf16x8 bw[2][6];
#pragma unroll
    for (int s = 0; s < 2; ++s)
#pragma unroll
      for (int ni = 0; ni < 6; ++ni) bw[s][ni] = *(const bf16x8*)(Wpt + ni * 16 * 256 + s * 32);
#pragma unroll
    for (int i = 0; i < 4; ++i) { int c = tid + i * NTHR, row = c >> 5, kc = c & 31;
      *(bf16x8*)(At + row * PB_ + kc * 16) = *(const bf16x8*)(U + (size_t)(m0 + row) * DIN + U_CQ + kc * 8); }
    __syncthreads();
    rows_rms(At, PB_, 4, 1.f / 256.f, rq);
    __syncthreads();
    f32x4 acc[6][4];
#pragma unroll
    for (int i = 0; i < 6; ++i)
#pragma unroll
      for (int j = 0; j < 4; ++j) acc[i][j] = f32x4{0.f, 0.f, 0.f, 0.f};
    const char* ap = At + l15 * PB_ + quad * 16;
#pragma unroll
    for (int ks = 0; ks < 8; ++ks) {
      bf16x8 af[4];
#pragma unroll
      for (int mi = 0; mi < 4; ++mi) af[mi] = *(const bf16x8*)(ap + mi * 16 * PB_ + ks * 64);
#pragma unroll
      for (int ni = 0; ni < 6; ++ni)
#pragma unroll
        for (int mi = 0; mi < 4; ++mi) acc[ni][mi] = mfma16(bw[ks & 1][ni], af[mi], acc[ni][mi]);
      if (ks + 2 < 8) {
#pragma unroll
        for (int ni = 0; ni < 6; ++ni) bw[ks & 1][ni] = *(const bf16x8*)(Wpt + ni * 16 * 256 + (ks + 2) * 32);
      }
      SBAR();
    }
    float whv[6][4];
#pragma unroll
    for (int ni = 0; ni < 6; ++ni)
#pragma unroll
      for (int j = 0; j < 4; ++j) whv[ni][j] = wh[ni * 16 + quad * 4 + j];
#pragma unroll
    for (int mi = 0; mi < 4; ++mi) {
      const int row = m0 + mi * 16 + l15; int b, pos; bool lat; row_info(row, b, lat, pos);
      const float r = rq[mi * 16 + l15];
      float ss = 0.f;
#pragma unroll
      for (int ni = 0; ni < 6; ++ni)
#pragma unroll
        for (int j = 0; j < 4; ++j) { float y = acc[ni][mi][j] * r; ss += y * y; }
      ss += __shfl_xor(ss, 16); ss += __shfl_xor(ss, 32);
      const float f = r * rsqrtf(ss * (1.f / DQK) + EPS) * QSCALE;
      float val[6][4];
#pragma unroll
      for (int ni = 0; ni < 6; ++ni)
#pragma unroll
        for (int j = 0; j < 4; ++j) val[ni][j] = acc[ni][mi][j] * f * whv[ni][j];
      if (lat) {
#pragma unroll
        for (int j = 0; j < 4; ++j) { float c, s; rope_cs(pos, quad * 4 + j, c, s);
          float x1 = val[4][j], x2 = val[5][j]; val[4][j] = x1 * c - x2 * s; val[5][j] = x2 * c + x1 * s; }
      }
      char* qs = stq + (mi * 16 + l15) * 208 + quad * 8;
#pragma unroll
      for (int ni = 0; ni < 6; ++ni) *(u32x2*)(qs + ni * 32) = pack4(val[ni][0], val[ni][1], val[ni][2], val[ni][3]);
    }
    { int b0, pos0; bool lat0; row_info(m0, b0, lat0, pos0);
      wave_tile_flush<96>(stq, Q + ((size_t)(b0 * NH + h) * NKEY + (lat0 ? CLEN + pos0 : pos0)) * DQK); }
    __syncthreads();
  }
}

DI void pc_kv(const Params& p, int l, char* lds) {
  const int tid = TIDX(), lane = tid & 63, h = tid >> 6, l15 = lane & 15, quad = lane >> 4;
  constexpr int PB_ = 336;
  char* At = lds; float* rkv = (float*)(lds + 64 * PB_);
  char* stk = lds + 35 * 1024 + h * (64 * 208);
  const bfraw* U = (const bfraw*)(p.ws + WS_U);
  const bfraw* W = (const bfraw*)(p.ws + WS_WUKV) + (size_t)l * 1024 * 128;
  bfraw* Kd = (bfraw*)(p.ws + WS_K); bfraw* Vd = (bfraw*)(p.ws + WS_V);
  const float* wh = p.k_head_norm_w + l * DQK;
  const int ntile = NTOK / 64;
  for (int t = (blockIdx.x + gridDim.x - (int)(gridDim.x / 3)) % gridDim.x; t < ntile; t += gridDim.x) {
    const int m0 = t * 64;
    const bfraw* Wpt = W + (size_t)(h * 128 + l15) * 128 + quad * 8; asm volatile("" : "+v"(Wpt));
    bf16x8 bw[4][4];
#pragma unroll
    for (int ks = 0; ks < 4; ++ks)
#pragma unroll
      for (int ni = 0; ni < 4; ++ni) bw[ks][ni] = *(const bf16x8*)(Wpt + ni * 16 * 128 + ks * 32);
    for (int c = tid; c < 64 * 20; c += NTHR) { int row = c / 20, kc = c % 20;
      *(bf16x8*)(At + row * PB_ + kc * 16) = *(const bf16x8*)(U + (size_t)(m0 + row) * DIN + U_CKV + kc * 8); }
    __syncthreads();
    rows_rms(At, PB_, 2, 1.f / 128.f, rkv);
    __syncthreads();
    const char* ap = At + l15 * PB_ + quad * 16;
#pragma unroll
    for (int pass = 0; pass < 2; ++pass) {
      f32x4 acc[4][4];
#pragma unroll
      for (int i = 0; i < 4; ++i)
#pragma unroll
        for (int j = 0; j < 4; ++j) acc[i][j] = f32x4{0.f, 0.f, 0.f, 0.f};
#pragma unroll
      for (int ks = 0; ks < 4; ++ks) {
        bf16x8 af[4];
#pragma unroll
        for (int mi = 0; mi < 4; ++mi) af[mi] = *(const bf16x8*)(ap + mi * 16 * PB_ + ks * 64);
#pragma unroll
        for (int ni = 0; ni < 4; ++ni)
#pragma unroll
          for (int mi = 0; mi < 4; ++mi) acc[ni][mi] = mfma16(bw[ks][ni], af[mi], acc[ni][mi]);
      }
      if (pass == 0) {
#pragma unroll
        for (int ks = 0; ks < 4; ++ks)
#pragma unroll
          for (int ni = 0; ni < 4; ++ni) bw[ks][ni] = *(const bf16x8*)(Wpt + (64 + ni * 16) * 128 + ks * 32);
      }
#pragma unroll
      for (int mi = 0; mi < 4; ++mi) {
        const int row = m0 + mi * 16 + l15; int b, pos; bool lat; row_info(row, b, lat, pos);
        const float r = rkv[mi * 16 + l15];
        const int key = lat ? CLEN + pos : pos;
        if (pass == 0) {
          const s16x4 k1 = *(const s16x4*)(At + (mi * 16 + l15) * PB_ + (128 + quad * 4) * 2);
          const s16x4 k2 = *(const s16x4*)(At + (mi * 16 + l15) * PB_ + (144 + quad * 4) * 2);
          float ss = 0.f;
#pragma unroll
          for (int ni = 0; ni < 4; ++ni)
#pragma unroll
            for (int j = 0; j < 4; ++j) { float y = acc[ni][mi][j] * r; ss += y * y; }
          float kr1[4], kr2[4];
#pragma unroll
          for (int j = 0; j < 4; ++j) { kr1[j] = bf2f(k1[j]); kr2[j] = bf2f(k2[j]); ss += kr1[j] * kr1[j] + kr2[j] * kr2[j]; }
          ss += __shfl_xor(ss, 16); ss += __shfl_xor(ss, 32);
          const float rinv = rsqrtf(ss * (1.f / DQK) + EPS);
          const float f = r * rinv;
          char* kd = stk + (mi * 16 + l15) * 208 + quad * 8;
#pragma unroll
          for (int ni = 0; ni < 4; ++ni) {
            const int n = ni * 16 + quad * 4;
            *(u32x2*)(kd + ni * 32) = pack4(acc[ni][mi][0] * f * wh[n], acc[ni][mi][1] * f * wh[n + 1], acc[ni][mi][2] * f * wh[n + 2], acc[ni][mi][3] * f * wh[n + 3]);
          }
          float x1[4], x2[4];
#pragma unroll
          for (int j = 0; j < 4; ++j) {
            const int d = quad * 4 + j;
            float a = kr1[j] * rinv * wh[64 + d], bb = kr2[j] * rinv * wh[80 + d];
            if (lat) { float c, s; rope_cs(pos, d, c, s); x1[j] = a * c - bb * s; x2[j] = bb * c + a * s; }
            else { x1[j] = a; x2[j] = bb; }
          }
          *(u32x2*)(kd + 128) = pack4(x1[0], x1[1], x1[2], x1[3]);
          *(u32x2*)(kd + 160) = pack4(x2[0], x2[1], x2[2], x2[3]);
        } else {
          char* vd = stk + (mi * 16 + l15) * 144 + quad * 8;
#pragma unroll
          for (int ni = 0; ni < 4; ++ni)
            *(u32x2*)(vd + ni * 32) = pack4(acc[ni][mi][0] * r, acc[ni][mi][1] * r, acc[ni][mi][2] * r, acc[ni][mi][3] * r);
        }
      }
      { int b0, pos0; bool lat0; row_info(m0, b0, lat0, pos0);
        const size_t key0 = (size_t)(b0 * NH + h) * NKEY + (lat0 ? CLEN + pos0 : pos0);
        if (pass == 0) wave_tile_flush<96>(stk, Kd + key0 * DQK); else wave_tile_flush<64>(stk, Vd + key0 * DV); }
    }
    __syncthreads();
  }
}

DI void pc_conv(const Params& p, int l, char* lds) {
  const int tid = TIDX(), lane = tid & 63, wid = tid >> 6, l15 = lane & 15, quad = lane >> 4;
  const bfraw* U = (const bfraw*)(p.ws + WS_U);
  bfraw* Y = (bfraw*)(p.ws + WS_H);
  const bfraw* Wpw = (const bfraw*)(p.ws + WS_WPW) + (size_t)l * 256 * 256;
  const float* scw = p.sc_conv_w + l * 3 * 256;
  const float* cfw = p.cf_conv_w + l * 31 * 256;
  const float* cfb = p.cf_conv_b + l * 256;
  const float* lnw = p.cf_ln_w + l * 256; const float* lnb = p.cf_ln_b + l * 256;
  const float* pwb = p.cf_pw_b + l * 256;
  bfraw* G = (bfraw*)lds;
  constexpr int APB = 528;
  float* Z = (float*)(lds + 48128);
  const int ntile = ((l == DEPTH - 1) ? NLAT : NTOK) / 64;
  bf16x8 wpw[8][2];
  {
    const bfraw* Wp = Wpw + (size_t)(wid * 32 + l15) * 256 + quad * 8;
#pragma unroll
    for (int ks = 0; ks < 8; ++ks)
#pragma unroll
      for (int ni = 0; ni < 2; ++ni) wpw[ks][ni] = *(const bf16x8*)(Wp + ni * 16 * 256 + ks * 32);
  }
  for (int t = (blockIdx.x + gridDim.x - (int)(2 * gridDim.x / 3)) % gridDim.x; t < ntile; t += gridDim.x) {
    const int tok0 = t * 64; int b, pos0; bool lat; row_info(tok0, b, lat, pos0);
    const int seq0 = tok0 - pos0, slen = lat ? TSEQ : CLEN;
#pragma unroll 2
    for (int i = 0; i < 4; ++i) {
      const int idx = tid + i * NTHR, tt = idx >> 5, c8 = (idx & 31) * 8, row = tok0 + tt, pos = pos0 + tt;
      const bfraw* ur = U + (size_t)row * DIN;
      bf16x8 ci = *(const bf16x8*)(ur + U_SCIN + c8), cc = *(const bf16x8*)(ur + U_SCC + c8);
      bf16x8 cb = *(const bf16x8*)(ur + U_SCB + c8), gb = *(const bf16x8*)(ur + U_GB + c8);
      bf16x8 pi = ci, pc = cc, ni_ = ci, nc = cc;
      const bool hp = pos > 0, hn = pos < slen - 1;
      if (hp) { pi = *(const bf16x8*)(ur - DIN + U_SCIN + c8); pc = *(const bf16x8*)(ur - DIN + U_SCC + c8); }
      if (hn) { ni_ = *(const bf16x8*)(ur + DIN + U_SCIN + c8); nc = *(const bf16x8*)(ur + DIN + U_SCC + c8); }
      float o[8];
#pragma unroll
      for (int j = 0; j < 8; ++j) {
        const int c = c8 + j;
        float pp = hp ? bf2f(pi[j]) * bf2f(pc[j]) : 0.f, pn = hn ? bf2f(ni_[j]) * bf2f(nc[j]) : 0.f, p0 = bf2f(ci[j]) * bf2f(cc[j]);
        float cv = scw[c] * pp + scw[256 + c] * p0 + scw[512 + c] * pn;
        o[j] = bf2f(cb[j]) * cv * silu_f(bf2f(gb[j]));
      }
      u32x4 w = {cvtpk(o[0], o[1]), cvtpk(o[2], o[3]), cvtpk(o[4], o[5]), cvtpk(o[6], o[7])};
      *(u32x4*)(Y + (size_t)row * DM + 512 + c8) = w;
    }
#pragma unroll 3
    for (int idx = tid; idx < 94 * 32; idx += NTHR) {
      const int rr = idx >> 5, c8 = (idx & 31) * 8, pos = pos0 - 15 + rr;
      u32x4 w = {0u, 0u, 0u, 0u};
      if (pos >= 0 && pos < slen) {
        const bfraw* ur = U + (size_t)(seq0 + pos) * DIN;
        bf16x8 a = *(const bf16x8*)(ur + U_CFA + c8), g = *(const bf16x8*)(ur + U_CFG + c8);
        float o[8];
#pragma unroll
        for (int j = 0; j < 8; ++j) o[j] = bf2f(a[j]) * sigmoid_f(bf2f(g[j]));
        w = u32x4{cvtpk(o[0], o[1]), cvtpk(o[2], o[3]), cvtpk(o[4], o[5]), cvtpk(o[6], o[7])};
      }
      *(u32x4*)(G + rr * 256 + c8) = w;
    }
    __syncthreads();
    {
      const int c = tid & 255, half = tid >> 8;
      float w[31];
#pragma unroll
      for (int k = 0; k < 31; ++k) w[k] = cfw[k * 256 + c];
      const float bias = cfb[c];
#pragma unroll 1
      for (int o0 = 0; o0 < 32; o0 += 4) {
        float a0 = bias, a1 = bias, a2 = bias, a3 = bias;
        const bfraw* gp = G + (half * 32 + o0) * 256 + c;
#pragma unroll
        for (int i = 0; i < 34; ++i) {
          const float v = bf2f((short)gp[i * 256]);
          if (i < 31) a0 += w[i] * v;
          if (i >= 1 && i < 32) a1 += w[i - 1] * v;
          if (i >= 2 && i < 33) a2 += w[i - 2] * v;
          if (i >= 3) a3 += w[i - 3] * v;
        }
        float* zp = Z + (half * 32 + o0) * 260 + c;
        zp[0] = a0; zp[260] = a1; zp[520] = a2; zp[780] = a3;
      }
    }
    __syncthreads();
    {
      f32x4 lw = *(const f32x4*)(lnw + lane * 4), lb = *(const f32x4*)(lnb + lane * 4);
#pragma unroll 1
      for (int i = 0; i < 8; ++i) {
        const int tt = wid * 8 + i;
        f32x4 z = *(const f32x4*)(Z + tt * 260 + lane * 4);
        float s = z[0] + z[1] + z[2] + z[3];
#pragma unroll
        for (int o = 32; o >= 1; o >>= 1) s += __shfl_xor(s, o);
        const float mu = s * (1.f / 256.f);
        float d0 = z[0] - mu, d1 = z[1] - mu, d2 = z[2] - mu, d3 = z[3] - mu;
        float q = d0 * d0 + d1 * d1 + d2 * d2 + d3 * d3;
#pragma unroll
        for (int o = 32; o >= 1; o >>= 1) q += __shfl_xor(q, o);
        const float rs = rsqrtf(q * (1.f / 256.f) + LN_EPS);
        float y0 = silu_f(d0 * rs * lw[0] + lb[0]), y1 = silu_f(d1 * rs * lw[1] + lb[1]);
        float y2 = silu_f(d2 * rs * lw[2] + lb[2]), y3 = silu_f(d3 * rs * lw[3] + lb[3]);
        *(u32x2*)((char*)G + tt * APB + lane * 8) = pack4(y0, y1, y2, y3);
      }
    }
    __syncthreads();
    {
      f32x4 acc[2][4];
#pragma unroll
      for (int i = 0; i < 2; ++i)
#pragma unroll
        for (int j = 0; j < 4; ++j) acc[i][j] = f32x4{0.f, 0.f, 0.f, 0.f};
      const char* ap = (const char*)G + l15 * APB + quad * 16;
#pragma unroll
      for (int ks = 0; ks < 8; ++ks) {
        bf16x8 af[4];
#pragma unroll
        for (int mi = 0; mi < 4; ++mi) af[mi] = *(const bf16x8*)(ap + mi * 16 * APB + ks * 64);
#pragma unroll
        for (int ni = 0; ni < 2; ++ni)
#pragma unroll
          for (int mi = 0; mi < 4; ++mi) acc[ni][mi] = mfma16(wpw[ks][ni], af[mi], acc[ni][mi]);
      }
#pragma unroll
      for (int ni = 0; ni < 2; ++ni) {
        const int n = wid * 32 + ni * 16 + quad * 4;
        const f32x4 pb = *(const f32x4*)(pwb + n);
#pragma unroll
        for (int mi = 0; mi < 4; ++mi) {
          const int row = tok0 + mi * 16 + l15;
          const s16x4 gc = *(const s16x4*)(U + (size_t)row * DIN + U_GC + n);
          float y0 = (acc[ni][mi][0] + pb[0]) * silu_f(bf2f(gc[0])), y1 = (acc[ni][mi][1] + pb[1]) * silu_f(bf2f(gc[1]));
          float y2 = (acc[ni][mi][2] + pb[2]) * silu_f(bf2f(gc[2])), y3 = (acc[ni][mi][3] + pb[3]) * silu_f(bf2f(gc[3]));
          *(u32x2*)(Y + (size_t)row * DM + 768 + n) = pack4(y0, y1, y2, y3);
        }
      }
    }
    __syncthreads();
  }
}

constexpr float ATT_SCALE = 0.10206207261596575f;
constexpr float ATT_THR = 8.f;
constexpr int SHM_V = 64 * 64 * 2, SHM_K = 64 * 256;
#define KSWZ(row, colB) ((row) * 256 + ((colB) ^ (((row) & 15) << 4)))
DI int crow(int r, int hi) { return (r & 3) + 8 * (r >> 2) + 4 * hi; }

template <bool FAST>
DI void partialSM(f32x16& p0, f32x16& p1, float& m_reg, float& mn, float& alpha) {
  if constexpr (!FAST) {
    float pmax = p0[0];
#pragma unroll
    for (int r = 1; r < 16; ++r) pmax = fmaxf(pmax, p0[r]);
#pragma unroll
    for (int r = 0; r < 16; ++r) pmax = fmaxf(pmax, p1[r]);
    { auto rr = __builtin_amdgcn_permlane32_swap(__float_as_uint(pmax), __float_as_uint(pmax), false, false);
      pmax = fmaxf(__uint_as_float(rr[0]), __uint_as_float(rr[1])); }
    if (__builtin_expect(__all(pmax - m_reg <= ATT_THR * 1.4426950408889634f), 1)) { mn = m_reg; alpha = 1.f; }
    else { mn = fmaxf(m_reg, pmax); alpha = __builtin_amdgcn_exp2f(m_reg - mn); m_reg = mn; }
#pragma unroll
    for (int r = 0; r < 16; ++r) p0[r] -= mn;
#pragma unroll
    for (int r = 0; r < 16; ++r) p1[r] -= mn;
  }
#pragma unroll
  for (int r = 0; r < 16; ++r) p0[r] = __builtin_amdgcn_exp2f(p0[r]);
}
template <bool FAST>
DI void finishSM(f32x16& p0, f32x16& p1, float alpha, float& l_reg, bf16x8& pa0, bf16x8& pa1, bf16x8& pa2, bf16x8& pa3) {
#pragma unroll
  for (int r = 0; r < 16; ++r) p1[r] = __builtin_amdgcn_exp2f(p1[r]);
  const f32x16 s16 = p0 + p1;
  using f32x8 = __attribute__((ext_vector_type(8))) float;
  using f32x2 = __attribute__((ext_vector_type(2))) float;
  const f32x8 s8 = __builtin_shufflevector(s16, s16, 0, 1, 2, 3, 4, 5, 6, 7) + __builtin_shufflevector(s16, s16, 8, 9, 10, 11, 12, 13, 14, 15);
  const f32x4 s4 = __builtin_shufflevector(s8, s8, 0, 1, 2, 3) + __builtin_shufflevector(s8, s8, 4, 5, 6, 7);
  const f32x2 s2 = __builtin_shufflevector(s4, s4, 0, 1) + __builtin_shufflevector(s4, s4, 2, 3);
  float ps = s2[0] + s2[1];
  if constexpr (FAST) { l_reg += ps; }
  else {
    auto rr = __builtin_amdgcn_permlane32_swap(__float_as_uint(ps), __float_as_uint(ps), false, false);
    ps = __uint_as_float(rr[0]) + __uint_as_float(rr[1]);
    l_reg = l_reg * alpha + ps;
  }
#define PK4(P, BASE, OUT) do { unsigned a0 = cvtpk(P[BASE + 0], P[BASE + 1]), a1 = cvtpk(P[BASE + 2], P[BASE + 3]);   \
    unsigned b0 = cvtpk(P[BASE + 4], P[BASE + 5]), b1 = cvtpk(P[BASE + 6], P[BASE + 7]);                              \
    auto r0 = __builtin_amdgcn_permlane32_swap(a0, b0, false, false); auto r1 = __builtin_amdgcn_permlane32_swap(a1, b1, false, false); \
    u32x4 w = {r0[0], r1[0], r0[1], r1[1]}; OUT = *reinterpret_cast<bf16x8*>(&w); } while (0)
  PK4(p0, 0, pa0); PK4(p0, 8, pa1); PK4(p1, 0, pa2); PK4(p1, 8, pa3);
#undef PK4
}
DI void qkt(f32x16& p0, f32x16& p1, const char* Ks, const bf16x8* qr, int r32, int hi) {
  p0 = f32x16{}; p1 = f32x16{};
#pragma unroll
  for (int d0 = 0; d0 < 6; ++d0) { int cb = (d0 * 16 + hi * 8) * 2;
    bf16x8 b0 = *reinterpret_cast<const bf16x8*>(Ks + KSWZ(r32, cb));
    bf16x8 b1 = *reinterpret_cast<const bf16x8*>(Ks + KSWZ(32 + r32, cb));
    p0 = __builtin_amdgcn_mfma_f32_32x32x16_bf16(b0, qr[d0], p0, 0, 0, 0);
    p1 = __builtin_amdgcn_mfma_f32_32x32x16_bf16(b1, qr[d0], p1, 0, 0, 0); }
}
DI int v_st(int k, int c) { const int kk = (k & ~0xC) | ((k & 4) << 1) | ((k & 8) >> 1); return ((kk >> 3) * 2 + (c >> 5)) * 512 + ((kk & 7) * 32 + (c & 31)) * 2; }
DI int v_st_acc(int k, int c) { return ((k >> 3) * 2 + (c >> 5)) * 512 + ((k & 7) * 32 + (c & 31)) * 2; }
DI int v_rd_base(int lane) { return ((lane & 3) << 3) | (((lane >> 2) & 3) << 6) | (((lane >> 4) & 1) << 5) | (((lane >> 5) & 1) << 8); }
constexpr int v_rd_off(int d0, int ks, int half) { return d0 * 512 + ks * 2048 + half * 1024; }
template <int OFF> DI s16x4 tr_read(int vb) {
  return __builtin_amdgcn_ds_read_tr16_b64_v4i16((__attribute__((address_space(3))) s16x4*)(unsigned)(vb + OFF));
}
template <int D0> DI void pv_one(f32x16& od, int vb, bf16x8 pa0, bf16x8 pa1, bf16x8 pa2, bf16x8 pa3) {
  const s16x4 l0 = tr_read<v_rd_off(D0, 0, 0)>(vb), h0 = tr_read<v_rd_off(D0, 0, 1)>(vb), l1 = tr_read<v_rd_off(D0, 1, 0)>(vb), h1 = tr_read<v_rd_off(D0, 1, 1)>(vb);
  const s16x4 l2 = tr_read<v_rd_off(D0, 2, 0)>(vb), h2 = tr_read<v_rd_off(D0, 2, 1)>(vb), l3 = tr_read<v_rd_off(D0, 3, 0)>(vb), h3 = tr_read<v_rd_off(D0, 3, 1)>(vb);
#define PK(L, H) (bf16x8){L[0], L[1], L[2], L[3], H[0], H[1], H[2], H[3]}
  od = __builtin_amdgcn_mfma_f32_32x32x16_bf16(pa0, PK(l0, h0), od, 0, 0, 0);
  od = __builtin_amdgcn_mfma_f32_32x32x16_bf16(pa1, PK(l1, h1), od, 0, 0, 0);
  od = __builtin_amdgcn_mfma_f32_32x32x16_bf16(pa2, PK(l2, h2), od, 0, 0, 0);
  od = __builtin_amdgcn_mfma_f32_32x32x16_bf16(pa3, PK(l3, h3), od, 0, 0, 0);
#undef PK
}
DI void pv_d0(f32x16* o, int vb, bf16x8 pa0, bf16x8 pa1, bf16x8 pa2, bf16x8 pa3) {
  pv_one<0>(o[0], vb, pa0, pa1, pa2, pa3); pv_one<1>(o[1], vb, pa0, pa1, pa2, pa3);
}

template <bool FAST>
DI void attn_body(const bfraw* __restrict__ Qb, const bfraw* __restrict__ Kh, const bfraw* __restrict__ Vh, int seq, char* lds,
                  const bfraw* __restrict__ U, bfraw* __restrict__ Y, int orow0, int h) {
  int tid_ = TIDX(); asm volatile("" : "+v"(tid_));
  const int tid = tid_, wid = __builtin_amdgcn_readfirstlane(tid >> 6), lane = tid & 63, r32 = lane & 31, hi = lane >> 5;
  char* V_lds = lds; char* K_lds = lds + 2 * SHM_V;
  float* ws = (float*)(lds + 2 * SHM_V + 2 * SHM_K) + wid * 64; float* li_l = ws; float* al_l = ws + 32;
  float m_reg = -1e30f, l_reg = 0; f32x16 o[2] = {}; bf16x8 qr[6];
  const bfraw* Qw = Qb + (size_t)(wid * 32 + r32) * DQK + hi * 8;
#pragma unroll
  for (int d0 = 0; d0 < 6; ++d0) qr[d0] = *(const bf16x8*)(Qw + d0 * 16);
  const int sr = tid >> 3, sc = (tid & 7) * 8;
  const int sr2 = (tid & 255) >> 2, sc2 = 64 + (tid & 3) * 8;
  const bool kx = wid < 4;
  const int vst = v_st(sr, sc), kst = KSWZ(sr, sc * 2), kst2 = KSWZ(sr2, sc2 * 2);
  const int vb0 = (int)(uintptr_t)V_lds + v_rd_base(lane);
  struct { bf16x8 vs, ks, ks2; } sr_[2];
  const unsigned voffg = (unsigned)(sr * DV + sc) * 2u, koffg = (unsigned)(sr * DQK + sc) * 2u, koffg2 = (unsigned)(sr2 * DQK + sc2) * 2u;
#define SLOAD(i, k0) do { const char* _vb = (const char*)Vh + (size_t)(k0) * (DV * 2); const char* _kb = (const char*)Kh + (size_t)(k0) * (DQK * 2); \
    sr_[i].vs = *(const bf16x8*)(_vb + voffg); sr_[i].ks = *(const bf16x8*)(_kb + koffg); \
    if (kx) sr_[i].ks2 = *(const bf16x8*)(_kb + koffg2); } while (0)
#define SWRITE(b, i) do { *(bf16x8*)(V_lds + (b) * SHM_V + vst) = sr_[i].vs; *(bf16x8*)(K_lds + (b) * SHM_K + kst) = sr_[i].ks; \
    if (kx) *(bf16x8*)(K_lds + (b) * SHM_K + kst2) = sr_[i].ks2; } while (0)
#define RESC(a) do { if (!FAST && __any((a) < 1.f)) { if (hi == 0) al_l[r32] = (a); asm volatile("s_waitcnt lgkmcnt(0)" ::: "memory"); \
    _Pragma("unroll") for (int d = 0; d < 2; ++d) _Pragma("unroll") for (int r = 0; r < 16; ++r) o[d][r] *= al_l[crow(r, hi)]; } } while (0)
  f32x16 pA0, pA1, pB0, pB1; float mnA, mnB, alA, alB; bf16x8 pa0, pa1, pa2, pa3; const int NT = seq / 64;
  constexpr int SE = 0, SO = 1;
  SLOAD(SE, 0); SWRITE(0, SE); __syncthreads();
  qkt(pA0, pA1, K_lds, qr, r32, hi); partialSM<FAST>(pA0, pA1, m_reg, mnA, alA);
  SLOAD(SO, 64); if (2 < NT) SLOAD(SE, 128);
  SWRITE(1, SO); __syncthreads();
  for (int j = 1; j + 1 < NT; j += 2) {
    SBAR(); qkt(pB0, pB1, K_lds + SHM_K, qr, r32, hi);
    finishSM<FAST>(pA0, pA1, alA, l_reg, pa0, pa1, pa2, pa3); SBAR();
    SLOAD(SO, (j + 2) * 64); SBAR();
    pv_d0(o, vb0, pa0, pa1, pa2, pa3); partialSM<FAST>(pB0, pB1, m_reg, mnB, alB);
    __syncthreads(); SWRITE(0, SE);
    RESC(alB); __syncthreads();
    SBAR(); qkt(pA0, pA1, K_lds, qr, r32, hi);
    finishSM<FAST>(pB0, pB1, alB, l_reg, pa0, pa1, pa2, pa3); SBAR();
    if (j + 3 < NT) SLOAD(SE, (j + 3) * 64); SBAR();
    pv_d0(o, vb0 + SHM_V, pa0, pa1, pa2, pa3); partialSM<FAST>(pA0, pA1, m_reg, mnA, alA);
    __syncthreads(); SWRITE(1, SO);
    RESC(alA); __syncthreads();
  }
  SBAR(); qkt(pB0, pB1, K_lds + SHM_K, qr, r32, hi);
  finishSM<FAST>(pA0, pA1, alA, l_reg, pa0, pa1, pa2, pa3); SBAR();
  pv_d0(o, vb0, pa0, pa1, pa2, pa3); partialSM<FAST>(pB0, pB1, m_reg, mnB, alB);
  __syncthreads(); RESC(alB);
  finishSM<FAST>(pB0, pB1, alB, l_reg, pa0, pa1, pa2, pa3); SBAR();
  pv_d0(o, vb0 + SHM_V, pa0, pa1, pa2, pa3);
  if constexpr (FAST) { auto rr = __builtin_amdgcn_permlane32_swap(__float_as_uint(l_reg), __float_as_uint(l_reg), false, false);
    l_reg = __uint_as_float(rr[0]) + __uint_as_float(rr[1]); }
  if (hi == 0) li_l[r32] = l_reg; asm volatile("s_waitcnt lgkmcnt(0)" ::: "memory");
#pragma unroll
  for (int r = 0; r < 16; ++r) {
    const int row = orow0 + wid * 32 + crow(r, hi);
    const float rli = __builtin_amdgcn_rcpf(li_l[crow(r, hi)]);
#pragma unroll
    for (int d0 = 0; d0 < 2; ++d0) {
      const int col = h * 64 + d0 * 32 + r32;
      const float g = bf2f((short)U[(size_t)row * DIN + U_GA + col]);
      Y[(size_t)row * DM + col] = f2bf(o[d0][r] * rli * silu_f(g));
    }
  }
  __syncthreads();
#undef SLOAD
#undef SWRITE
#undef RESC
}

template <int D0> DI void pv2_one(f32x16& oa, f32x16& ob, int vb, const bf16x8 (&pa)[4], const bf16x8 (&pb)[4]) {
  const s16x4 l0 = tr_read<v_rd_off(D0, 0, 0)>(vb), h0 = tr_read<v_rd_off(D0, 0, 1)>(vb), l1 = tr_read<v_rd_off(D0, 1, 0)>(vb), h1 = tr_read<v_rd_off(D0, 1, 1)>(vb);
  const s16x4 l2 = tr_read<v_rd_off(D0, 2, 0)>(vb), h2 = tr_read<v_rd_off(D0, 2, 1)>(vb), l3 = tr_read<v_rd_off(D0, 3, 0)>(vb), h3 = tr_read<v_rd_off(D0, 3, 1)>(vb);
#define PK(L, H) (bf16x8){L[0], L[1], L[2], L[3], H[0], H[1], H[2], H[3]}
  oa = __builtin_amdgcn_mfma_f32_32x32x16_bf16(pa[0], PK(l0, h0), oa, 0, 0, 0);
  ob = __builtin_amdgcn_mfma_f32_32x32x16_bf16(pb[0], PK(l0, h0), ob, 0, 0, 0);
  oa = __builtin_amdgcn_mfma_f32_32x32x16_bf16(pa[1], PK(l1, h1), oa, 0, 0, 0);
  ob = __builtin_amdgcn_mfma_f32_32x32x16_bf16(pb[1], PK(l1, h1), ob, 0, 0, 0);
  oa = __builtin_amdgcn_mfma_f32_32x32x16_bf16(pa[2], PK(l2, h2), oa, 0, 0, 0);
  ob = __builtin_amdgcn_mfma_f32_32x32x16_bf16(pb[2], PK(l2, h2), ob, 0, 0, 0);
  oa = __builtin_amdgcn_mfma_f32_32x32x16_bf16(pa[3], PK(l3, h3), oa, 0, 0, 0);
  ob = __builtin_amdgcn_mfma_f32_32x32x16_bf16(pb[3], PK(l3, h3), ob, 0, 0, 0);
#undef PK
}
DI void sm_accB(f32x16& p0, f32x16& p1, float& l_reg, bf16x8 (&pf)[4]) {
#pragma unroll
  for (int r = 0; r < 16; ++r) p0[r] = __builtin_amdgcn_exp2f(p0[r]);
#pragma unroll
  for (int r = 0; r < 16; ++r) p1[r] = __builtin_amdgcn_exp2f(p1[r]);
  const f32x16 s16 = p0 + p1;
  using f32x8 = __attribute__((ext_vector_type(8))) float;
  using f32x2 = __attribute__((ext_vector_type(2))) float;
  const f32x8 s8 = __builtin_shufflevector(s16, s16, 0, 1, 2, 3, 4, 5, 6, 7) + __builtin_shufflevector(s16, s16, 8, 9, 10, 11, 12, 13, 14, 15);
  const f32x4 s4 = __builtin_shufflevector(s8, s8, 0, 1, 2, 3) + __builtin_shufflevector(s8, s8, 4, 5, 6, 7);
  const f32x2 s2 = __builtin_shufflevector(s4, s4, 0, 1) + __builtin_shufflevector(s4, s4, 2, 3);
  l_reg += s2[0] + s2[1];
#define PKS(P, S, OUT) do { u32x4 w = {cvtpk(P[8 * S + 0], P[8 * S + 1]), cvtpk(P[8 * S + 2], P[8 * S + 3]), cvtpk(P[8 * S + 4], P[8 * S + 5]), cvtpk(P[8 * S + 6], P[8 * S + 7])}; \
    OUT = *reinterpret_cast<bf16x8*>(&w); } while (0)
  PKS(p0, 0, pf[0]); PKS(p0, 1, pf[1]); PKS(p1, 0, pf[2]); PKS(p1, 1, pf[3]);
#undef PKS
}
template <int D0> DI void pvT2_one(f32x16& oa, f32x16& ob, int vb, const bf16x8 (&pa)[4], const bf16x8 (&pb)[4]) {
  const s16x4 l0 = tr_read<v_rd_off(D0, 0, 0)>(vb), h0 = tr_read<v_rd_off(D0, 0, 1)>(vb), l1 = tr_read<v_rd_off(D0, 1, 0)>(vb), h1 = tr_read<v_rd_off(D0, 1, 1)>(vb);
  const s16x4 l2 = tr_read<v_rd_off(D0, 2, 0)>(vb), h2 = tr_read<v_rd_off(D0, 2, 1)>(vb), l3 = tr_read<v_rd_off(D0, 3, 0)>(vb), h3 = tr_read<v_rd_off(D0, 3, 1)>(vb);
#define PK(L, H) (bf16x8){L[0], L[1], L[2], L[3], H[0], H[1], H[2], H[3]}
  oa = __builtin_amdgcn_mfma_f32_32x32x16_bf16(PK(l0, h0), pa[0], oa, 0, 0, 0);
  ob = __builtin_amdgcn_mfma_f32_32x32x16_bf16(PK(l0, h0), pb[0], ob, 0, 0, 0);
  oa = __builtin_amdgcn_mfma_f32_32x32x16_bf16(PK(l1, h1), pa[1], oa, 0, 0, 0);
  ob = __builtin_amdgcn_mfma_f32_32x32x16_bf16(PK(l1, h1), pb[1], ob, 0, 0, 0);
  oa = __builtin_amdgcn_mfma_f32_32x32x16_bf16(PK(l2, h2), pa[2], oa, 0, 0, 0);
  ob = __builtin_amdgcn_mfma_f32_32x32x16_bf16(PK(l2, h2), pb[2], ob, 0, 0, 0);
  oa = __builtin_amdgcn_mfma_f32_32x32x16_bf16(PK(l3, h3), pa[3], oa, 0, 0, 0);
  ob = __builtin_amdgcn_mfma_f32_32x32x16_bf16(PK(l3, h3), pb[3], ob, 0, 0, 0);
#undef PK
}
DI void attn_body64(const bfraw* __restrict__ Qb, const bfraw* __restrict__ Kh, const bfraw* __restrict__ Vh, int seq, int nrows, char* lds,
                    const bfraw* __restrict__ U, bfraw* __restrict__ Y, int orow0, int h) {
  int tid_ = TIDX(); asm volatile("" : "+v"(tid_));
  const int tid = tid_, wid = __builtin_amdgcn_readfirstlane(tid >> 6), lane = tid & 63, r32 = lane & 31, hi = lane >> 5;
  char* V_lds = lds; char* K_lds = lds + 3 * SHM_V;
  float* li_l = (float*)(lds + 3 * SHM_V + 3 * SHM_K) + wid * 64;
  const bool active = wid * 64 < nrows;
  float lA = 0.f, lB = 0.f; f32x16 oA[2] = {}, oB[2] = {}; bf16x8 qA[6], qB[6];
  {
    const bfraw* Qw = Qb + (size_t)((active ? wid * 64 : 0) + r32) * DQK + hi * 8;
#pragma unroll
    for (int d0 = 0; d0 < 6; ++d0) { qA[d0] = *(const bf16x8*)(Qw + d0 * 16); qB[d0] = *(const bf16x8*)(Qw + 32 * DQK + d0 * 16); }
  }
  const int t8 = tid & 255, srow = t8 >> 2, sq = t8 & 3;
  const int vb0 = (int)(uintptr_t)V_lds + v_rd_base(lane);
  bf16x8 gv0, gv1, gk0, gk1, gk2;
  const unsigned vog = (unsigned)(srow * DV + sq * 16) * 2u, kog = (unsigned)(srow * DQK + sq * 24) * 2u;
  const int vs0 = v_st_acc(srow, sq * 16), vs1 = v_st_acc(srow, sq * 16 + 8);
  const int ks0 = KSWZ(srow, (sq * 24) * 2), ks1 = KSWZ(srow, (sq * 24 + 8) * 2), ks2 = KSWZ(srow, (sq * 24 + 16) * 2);
#define SLOAD(k0) do { const char* _vb = (const char*)Vh + (size_t)(k0) * (DV * 2) + vog; const char* _kb = (const char*)Kh + (size_t)(k0) * (DQK * 2) + kog; \
    gv0 = *(const bf16x8*)(_vb); gv1 = *(const bf16x8*)(_vb + 16); gk0 = *(const bf16x8*)(_kb); gk1 = *(const bf16x8*)(_kb + 16); gk2 = *(const bf16x8*)(_kb + 32); } while (0)
#define SWRITE(b) do { *(bf16x8*)(V_lds + (b) * SHM_V + vs0) = gv0; *(bf16x8*)(V_lds + (b) * SHM_V + vs1) = gv1; \
    *(bf16x8*)(K_lds + (b) * SHM_K + ks0) = gk0; *(bf16x8*)(K_lds + (b) * SHM_K + ks1) = gk1; *(bf16x8*)(K_lds + (b) * SHM_K + ks2) = gk2; } while (0)
  const int NT = seq / 64;
  f32x16 sA0 = {}, sA1 = {}, sB0 = {}, sB1 = {};
#define QK_TILE(slot) do { const char* Ks = K_lds + (slot) * SHM_K; sA0 = f32x16{}; sA1 = f32x16{}; sB0 = f32x16{}; sB1 = f32x16{}; \
    bf16x8 kf[2][2]; \
    _Pragma("unroll") for (int d0 = 0; d0 < 2; ++d0) { const int cb = (d0 * 16 + hi * 8) * 2; \
      kf[d0][0] = *reinterpret_cast<const bf16x8*>(Ks + KSWZ(r32, cb)); kf[d0][1] = *reinterpret_cast<const bf16x8*>(Ks + KSWZ(32 + r32, cb)); } \
    _Pragma("unroll") for (int d0 = 0; d0 < 6; ++d0) { const bf16x8 b0 = kf[d0 & 1][0], b1 = kf[d0 & 1][1]; \
      sA0 = __builtin_amdgcn_mfma_f32_32x32x16_bf16(b0, qA[d0], sA0, 0, 0, 0); \
      sA1 = __builtin_amdgcn_mfma_f32_32x32x16_bf16(b1, qA[d0], sA1, 0, 0, 0); \
      sB0 = __builtin_amdgcn_mfma_f32_32x32x16_bf16(b0, qB[d0], sB0, 0, 0, 0); \
      sB1 = __builtin_amdgcn_mfma_f32_32x32x16_bf16(b1, qB[d0], sB1, 0, 0, 0); \
      if (d0 + 2 < 6) { const int cb = ((d0 + 2) * 16 + hi * 8) * 2; \
        kf[d0 & 1][0] = *reinterpret_cast<const bf16x8*>(Ks + KSWZ(r32, cb)); kf[d0 & 1][1] = *reinterpret_cast<const bf16x8*>(Ks + KSWZ(32 + r32, cb)); } } } while (0)
#define SM_PV_TILE(slot) do { bf16x8 pa[4], pb[4]; sm_accB(sA0, sA1, lA, pa); sm_accB(sB0, sB1, lB, pb); \
    const int vb = vb0 + (slot) * SHM_V; \
    pvT2_one<0>(oA[0], oB[0], vb, pa, pb); pvT2_one<1>(oA[1], oB[1], vb, pa, pb); } while (0)
  if (wid >= 4) {
    __syncthreads();
    int bt = 0;
    for (int t = 0; t < NT; ++t) {
      const int bn = (bt == 2) ? 0 : bt + 1, bp = (bt == 0) ? 2 : bt - 1;
      if (active) { if (t > 0) SM_PV_TILE(bp); QK_TILE(bt); }
      __syncthreads();
      bt = bn;
    }
    if (active) { const int bl = (bt == 0) ? 2 : bt - 1; SM_PV_TILE(bl); }
  } else {
    SLOAD(0); SWRITE(0); SLOAD(64);
    __syncthreads();
    int bt = 0;
    for (int t = 0; t < NT; ++t) {
      const int bn = (bt == 2) ? 0 : bt + 1;
      QK_TILE(bt);
      { bf16x8 pa[4], pb[4]; sm_accB(sA0, sA1, lA, pa); sm_accB(sB0, sB1, lB, pb);
        if (t + 1 < NT) { SWRITE(bn); if (t + 2 < NT) SLOAD((t + 2) * 64); }
        const int vb = vb0 + bt * SHM_V;
        pvT2_one<0>(oA[0], oB[0], vb, pa, pb); pvT2_one<1>(oA[1], oB[1], vb, pa, pb); }
      __syncthreads();
      bt = bn;
    }
  }
#undef QK_TILE
#undef SM_PV_TILE
  if (active) {
    { auto rr = __builtin_amdgcn_permlane32_swap(__float_as_uint(lA), __float_as_uint(lA), false, false); lA = __uint_as_float(rr[0]) + __uint_as_float(rr[1]); }
    { auto rr = __builtin_amdgcn_permlane32_swap(__float_as_uint(lB), __float_as_uint(lB), false, false); lB = __uint_as_float(rr[0]) + __uint_as_float(rr[1]); }
#pragma unroll
    for (int g = 0; g < 2; ++g) {
      const int row = orow0 + wid * 64 + g * 32 + r32;
      const float rli = __builtin_amdgcn_rcpf(g == 0 ? lA : lB);
      const bfraw* up = U + (size_t)row * DIN + U_GA + h * 64 + 4 * hi;
      bfraw* yp = Y + (size_t)row * DM + h * 64 + 4 * hi;
#pragma unroll
      for (int d0 = 0; d0 < 2; ++d0)
#pragma unroll
        for (int q4 = 0; q4 < 4; ++q4) {
          const s16x4 gg = *(const s16x4*)(up + d0 * 32 + q4 * 8);
          float v[4];
#pragma unroll
          for (int j = 0; j < 4; ++j) { const float ov = (g == 0) ? oA[d0][q4 * 4 + j] : oB[d0][q4 * 4 + j]; v[j] = ov * rli * silu_f(bf2f(gg[j])); }
          *(u32x2*)(yp + d0 * 32 + q4 * 8) = pack4(v[0], v[1], v[2], v[3]);
        }
    }
  }
  __syncthreads();
#undef SLOAD
#undef SWRITE
}

DI void pd_attn(const Params& p, int l, char* lds) {
  const bfraw* Q = (const bfraw*)(p.ws + WS_Q); const bfraw* Kd = (const bfraw*)(p.ws + WS_K); const bfraw* Vd = (const bfraw*)(p.ws + WS_V);
  const bfraw* U = (const bfraw*)(p.ws + WS_U); bfraw* Y = (bfraw*)(p.ws + WS_H);
  const int nitem = 1024 + ((l == DEPTH - 1) ? 0 : 32);
  float mq = 0.f, mk = 0.f;
  for (int i = 0; i < DQK; ++i) { mq = fmaxf(mq, fabsf(p.q_head_norm_w[l * DQK + i])); mk = fmaxf(mk, fabsf(p.k_head_norm_w[l * DQK + i])); }
  const bool fast = (float)DQK * QSCALE * mq * mk * 1.05f < 60.f;
  if (fast) {
    const int nitem = 512 + ((l == DEPTH - 1) ? 0 : 32);
    for (int it = blockIdx.x; it < nitem; it += gridDim.x) {
      int b, h, q0, seq, orow0, nrows;
      if (it < 512) { b = it >> 7; h = it & 7; const int qb = (it >> 3) & 15; q0 = CLEN + qb * 512; seq = NKEY; orow0 = b * TSEQ + qb * 512; nrows = 512; }
      else { const int c = it - 512; b = c >> 3; h = c & 7; q0 = 0; seq = CLEN; orow0 = NLAT + b * CLEN; nrows = 256; }
      const size_t bh = (size_t)(b * NH + h) * NKEY;
      attn_body64(Q + (bh + q0) * DQK, Kd + bh * DQK, Vd + bh * DV, seq, nrows, lds, U, Y, orow0, h);
    }
  } else {
    for (int it = blockIdx.x; it < nitem; it += gridDim.x) {
      int b, h, q0, seq, orow0;
      if (it < 1024) { b = it >> 8; h = it & 7; const int qb = (it >> 3) & 31; q0 = CLEN + qb * 256; seq = NKEY; orow0 = b * TSEQ + qb * 256; }
      else { const int c = it - 1024; b = c >> 3; h = c & 7; q0 = 0; seq = CLEN; orow0 = NLAT + b * CLEN; }
      const size_t bh = (size_t)(b * NH + h) * NKEY;
      attn_body<false>(Q + (bh + q0) * DQK, Kd + bh * DQK, Vd + bh * DV, seq, lds, U, Y, orow0, h);
    }
  }
}

#define XB_TMO      128
#define XB_XCNT(j)  (256  + 64 * (j))
#define XB_XSUB(j)  (1280 + 64 * (j))
#define XB_XGEN(j)  (2304 + 64 * (j))
#define XB_TOP      3328
#define XB_TOPGEN   3392
#define XCD_BAR_WORDS 3456
#define XB_SPIN_CAP (1u << 18)
#define LAS __attribute__((address_space(3)))

__device__ __forceinline__ unsigned xb_ld(unsigned* p)              { return __hip_atomic_load(p, __ATOMIC_RELAXED, __HIP_MEMORY_SCOPE_AGENT); }
__device__ __forceinline__ unsigned xb_add(unsigned* p, unsigned v) { return __hip_atomic_fetch_add(p, v, __ATOMIC_RELAXED, __HIP_MEMORY_SCOPE_AGENT); }
__device__ __forceinline__ unsigned xb_xcc_id() { return (unsigned)__builtin_amdgcn_s_getreg((3 << 11) | 20) & 0xFu; }
#define XB_SPIN(cond, bar) do { unsigned _sp = 0; while (cond) { __builtin_amdgcn_s_sleep(1); \
    if ((++_sp & 255u) == 0u) { if (xb_ld(&(bar)[XB_TMO])) break; if (_sp > XB_SPIN_CAP) { atomicAdd(&(bar)[XB_TMO], 1u); break; } } } } while (0)

struct XcdBarrier {
    unsigned* bar; unsigned x;
    volatile LAS unsigned* st;
};

__device__ __forceinline__ XcdBarrier xcd_barrier_post(unsigned* bar, volatile LAS unsigned* st) {
    XcdBarrier b; b.bar = bar; b.x = xb_xcc_id(); b.st = st;
    if (TIDX() == 0) (void)xb_add(&bar[XB_XCNT(b.x)], 1u);
    return b;
}
__device__ __forceinline__ void xcd_barrier_complete(unsigned* bar, unsigned x, unsigned& nloc, unsigned& nx) {
    const unsigned G = gridDim.x * gridDim.y * gridDim.z;
    unsigned sum, cnt, mine, sp = 0u;
    for (;;) {
        sum = 0u; cnt = 0u; mine = 0u;
#pragma unroll
        for (unsigned j = 0; j < 16; ++j) { const unsigned c = xb_ld(&bar[XB_XCNT(j)]); sum += c; cnt += (c > 0u) ? 1u : 0u; mine = (j == x) ? c : mine; }
        if (sum == G) break;
        __builtin_amdgcn_s_sleep(1);
        if ((++sp & 255u) == 0u) { if (xb_ld(&bar[XB_TMO])) break; if (sp > XB_SPIN_CAP) { atomicAdd(&bar[XB_TMO], 1u); break; } }
    }
    nloc = mine > 0u ? mine : 1u; nx = cnt > 0u ? cnt : 1u;
}

__device__ __forceinline__ void xcd_barrier(const XcdBarrier& b) {
    asm volatile("s_waitcnt vmcnt(0)" ::: "memory");
    __syncthreads();
    if (TIDX() == 0) {
        unsigned* bar = b.bar;
        __builtin_amdgcn_s_waitcnt(0);
        unsigned nloc = b.st[0], nx = b.st[1];
        if (nloc == 0u) { xcd_barrier_complete(bar, b.x, nloc, nx); b.st[0] = nloc; b.st[1] = nx; }
        const unsigned old = xb_add(&bar[XB_XSUB(b.x)], 1u);
        const unsigned gen = old / nloc;
        if (old + 1u == (gen + 1u) * nloc) {
            __builtin_amdgcn_fence(__ATOMIC_RELEASE, "agent");
            asm volatile("s_waitcnt vmcnt(0)" ::: "memory");
            const unsigned og = xb_add(&bar[XB_TOP], 1u);
            const unsigned tg = og / nx;
            if (og + 1u == (tg + 1u) * nx) xb_add(&bar[XB_TOPGEN], 1u);
            else XB_SPIN(xb_ld(&bar[XB_TOPGEN]) == tg, bar);
            __builtin_amdgcn_fence(__ATOMIC_ACQUIRE, "agent");
            xb_add(&bar[XB_XGEN(b.x)], 1u);
            asm volatile("s_waitcnt vmcnt(0)" ::: "memory");
        } else {
            XB_SPIN(xb_ld(&bar[XB_XGEN(b.x)]) == gen, bar);
            __builtin_amdgcn_fence(__ATOMIC_ACQUIRE, "agent");
            asm volatile("s_waitcnt vmcnt(0)" ::: "memory");
        }
    }
    __syncthreads();
}

__global__ void __launch_bounds__(NTHR) mega(Params p) {
  extern __shared__ __attribute__((aligned(16))) char lds[];
  const int lo = p.ph_lo, hi = p.ph_hi;
  const bool fused = (lo == 0 && hi == 1 + 5 * DEPTH);
  volatile LAS unsigned* st = (volatile LAS unsigned*)(lds + LDS_PHASE_BYTES);
  if (TIDX() == 0) { st[0] = 0u; st[1] = 0u; }
  __syncthreads();
#define SEAM() do { XcdBarrier b_; b_.bar = (unsigned*)(p.ws + WS_BAR); b_.x = xb_xcc_id(); b_.st = (volatile LAS unsigned*)(lds + LDS_PHASE_BYTES); xcd_barrier(b_); } while (0)
#define PHASE(k, call) if (lo <= (k) && (k) < hi) { if (fused && (k) > 1) SEAM(); call; }
  if (lo == 0) {
    p0_prologue(p, lds);
    if (fused) {
      unsigned* barw = (unsigned*)(p.ws + WS_BAR);
      if (blockIdx.x == 0) for (int i = TIDX(); i < XCD_BAR_WORDS; i += NTHR) barw[i] = 0u;
      cg::this_grid().sync();
      (void)xcd_barrier_post(barw, st);
    }
  }
  PHASE(1, pa_norm(p, 0))
  PHASE(2, pb_inproj(p, 0, lds))
  PHASE(3, (pc_q(p, 0, lds), pc_kv(p, 0, lds), pc_conv(p, 0, lds)))
  PHASE(4, pd_attn(p, 0, lds))
  PHASE(5, pe_outproj(p, 0, lds))
  PHASE(6, pa_norm(p, 1))
  PHASE(7, pb_inproj(p, 1, lds))
  PHASE(8, (pc_q(p, 1, lds), pc_kv(p, 1, lds), pc_conv(p, 1, lds)))
  PHASE(9, pd_attn(p, 1, lds))
  PHASE(10, pe_outproj(p, 1, lds))
#undef PHASE
#undef SEAM
}

extern "C" void kernel_launch(void* const* d_in, const int* in_sizes, int n_in, void* d_out, int out_size, void* d_ws, size_t ws_size,
                              hipStream_t stream) {
  static int grid_blocks = 0;
  if (grid_blocks == 0) {
    if (n_in != 22 || out_size != NLAT * DM || ws_size < WS_END) {
      fprintf(stderr, "kernel_launch: unexpected shapes n_in %d out %d ws %zu (need %zu)\n", n_in, out_size, ws_size, (size_t)WS_END); grid_blocks = -1; return; }
    int dev = 0, cus = 0, per_cu = 0;
    hipGetDevice(&dev);
    hipDeviceGetAttribute(&cus, hipDeviceAttributeMultiprocessorCount, dev);
    if (hipFuncSetAttribute((const void*)mega, hipFuncAttributeMaxDynamicSharedMemorySize, LDS_BYTES) != hipSuccess) {
      fprintf(stderr, "kernel_launch: hipFuncSetAttribute failed\n"); grid_blocks = -1; return; }
    hipOccupancyMaxActiveBlocksPerMultiprocessor(&per_cu, (const void*)mega, NTHR, LDS_BYTES);
    if (per_cu < 1) per_cu = 1;
    grid_blocks = cus * per_cu;
    (void)hipGetLastError();
  }
  if (grid_blocks < 0) return;
  Params p{};
  const float** pp = (const float**)&p;
  for (int i = 0; i < 22; ++i) pp[i] = (const float*)d_in[i];
  p.out = (float*)d_out; p.ws = (unsigned char*)d_ws;
  constexpr int NPH = 1 + 5 * DEPTH;
#if ONE_LAUNCH
  p.ph_lo = 0; p.ph_hi = NPH;
  void* args[] = {&p};
  hipError_t e = hipLaunchCooperativeKernel((const void*)mega, dim3(grid_blocks), dim3(NTHR), args, LDS_BYTES, stream);
  if (e != hipSuccess) fprintf(stderr, "cooperative launch failed: %s (grid %d)\n", hipGetErrorString(e), grid_blocks);
#else
  for (int ph = 0; ph < NPH; ++ph) {
    p.ph_lo = ph; p.ph_hi = ph + 1;
    hipLaunchKernelGGL(mega, dim3(grid_blocks), dim3(NTHR), LDS_BYTES, stream, p);
  }
#endif
}
```

```cpp
#include <hip/hip_runtime.h>
#include <hip/hip_bf16.h>
#include <hip/hip_cooperative_groups.h>
#include <cstdio>
#include <cstdint>
namespace cg = cooperative_groups;

#ifndef ONE_LAUNCH
#define ONE_LAUNCH 1
#endif

constexpr int DM = 1024, NBATCH = 4, TSEQ = 8192, CLEN = 256, DEPTH = 2;
constexpr int NLAT = NBATCH * TSEQ;
constexpr int NCTX = NBATCH * CLEN;
constexpr int NTOK = NLAT + NCTX;
constexpr int DIN = 2720, DINP = 2816;
constexpr int NH = 8, DQK = 96, DV = 64, NKEY = CLEN + TSEQ;
constexpr int U_CQ = 0, U_CKV = 256, U_KR = 384, U_GA = 416, U_SCIN = 928, U_SCB = 1184, U_SCC = 1440, U_GB = 1696,
              U_CFA = 1952, U_CFG = 2208, U_GC = 2464;
constexpr float EPS = 1e-6f, LN_EPS = 1e-5f;
constexpr float QSCALE = 0.10206207261596575f * 1.4426950408889634f;
constexpr int NTHR = 512;

constexpr size_t AL(size_t x) { return (x + 255) / 256 * 256; }
constexpr size_t WS_WIN  = 0;
constexpr size_t WS_WUQ  = WS_WIN  + AL((size_t)DEPTH * DINP * DM * 2);
constexpr size_t WS_WUKV = WS_WUQ  + AL((size_t)DEPTH * 768 * 256 * 2);
constexpr size_t WS_WPW  = WS_WUKV + AL((size_t)DEPTH * 1024 * 128 * 2);
constexpr size_t WS_WOUT = WS_WPW  + AL((size_t)DEPTH * 256 * 256 * 2);
constexpr size_t WS_MOD  = WS_WOUT + AL((size_t)DEPTH * DM * DM * 2);
constexpr size_t WS_H    = WS_MOD  + AL((size_t)DEPTH * 5 * 3072 * 4);
constexpr size_t WS_U    = WS_H    + AL((size_t)NTOK * DM * 2);
constexpr size_t WS_Q    = WS_U    + AL((size_t)NTOK * DIN * 2);
constexpr size_t WS_K    = WS_Q    + AL((size_t)NBATCH * NH * NKEY * DQK * 2);
constexpr size_t WS_V    = WS_K    + AL((size_t)NBATCH * NH * NKEY * DQK * 2);
constexpr size_t WS_XC1  = WS_V    + AL((size_t)NBATCH * NH * NKEY * DV * 2);
constexpr size_t WS_BAR  = WS_XC1  + AL((size_t)NCTX * DM * 4);
constexpr size_t WS_END  = WS_BAR  + AL((size_t)4096 * 4);

constexpr int LDS_PHASE_BYTES = 144 * 1024, LDS_BYTES = LDS_PHASE_BYTES + 16;

using bf16x8 = __attribute__((ext_vector_type(8))) short;
using s16x4  = __attribute__((ext_vector_type(4))) short;
using f32x4  = __attribute__((ext_vector_type(4))) float;
using f32x16 = __attribute__((ext_vector_type(16))) float;
using u32x4  = __attribute__((ext_vector_type(4))) unsigned;
using u32x2  = __attribute__((ext_vector_type(2))) unsigned;
typedef unsigned short bfraw;
#define DI __device__ __forceinline__
#define SBAR() __builtin_amdgcn_sched_barrier(0)

DI int tid_opaque() { int t = __builtin_amdgcn_workitem_id_x(); asm volatile("" : "+v"(t)); return t; }
#define TIDX() tid_opaque()
DI float bf2f(short s) { return __uint_as_float(((unsigned)(unsigned short)s) << 16); }
DI bfraw f2bf(float x) { unsigned u = __float_as_uint(x); u += 0x7fffu + ((u >> 16) & 1u); return (bfraw)(u >> 16); }
DI unsigned cvtpk(float lo, float hi) { unsigned r; asm("v_cvt_pk_bf16_f32 %0, %1, %2" : "=v"(r) : "v"(lo), "v"(hi)); return r; }
DI u32x2 pack4(float a, float b, float c, float d) { u32x2 r = {cvtpk(a, b), cvtpk(c, d)}; return r; }
DI float silu_f(float x) { return x * __builtin_amdgcn_rcpf(1.f + __expf(-x)); }
DI float sigmoid_f(float x) { return __builtin_amdgcn_rcpf(1.f + __expf(-x)); }
DI f32x4 mfma16(bf16x8 a, bf16x8 b, f32x4 c) { return __builtin_amdgcn_mfma_f32_16x16x32_bf16(a, b, c, 0, 0, 0); }

struct Params {
  const float* x; const float* c; const float* ctx; const float* c_ctx; const float* norm_w; const float* w_mod; const float* b_mod;
  const float* w_in; const float* q_norm_w; const float* w_uq; const float* kv_norm_w; const float* w_ukv; const float* q_head_norm_w;
  const float* k_head_norm_w; const float* sc_conv_w; const float* cf_conv_w; const float* cf_conv_b; const float* cf_ln_w;
  const float* cf_ln_b; const float* cf_pw_w; const float* cf_pw_b; const float* w_out;
  float* out; unsigned char* ws; int ph_lo, ph_hi;
};

DI void row_info(int row, int& b, bool& lat, int& pos) {
  if (row < NLAT) { lat = true; b = row >> 13; pos = row & (TSEQ - 1); }
  else { int c = row - NLAT; lat = false; b = c >> 8; pos = c & (CLEN - 1); }
}

struct TrJob { const float* src; bfraw* dst; const float* scale; int K, N, k0, n0; };
DI TrJob tr_decode(const Params& p, int it) {
  constexpr int PER_L = 1056;
  const int l = it / PER_L, r = it % PER_L; TrJob j;
  if (r < 704) { int kt = r / 44, nt = r % 44; j = TrJob{p.w_in + (size_t)l * DM * DIN, (bfraw*)(p.ws + WS_WIN) + (size_t)l * DINP * DM, nullptr, DM, DIN, kt * 64, nt * 64}; }
  else if (r < 752) { int rr = r - 704, kt = rr / 12, nt = rr % 12; j = TrJob{p.w_uq + (size_t)l * 256 * 768, (bfraw*)(p.ws + WS_WUQ) + (size_t)l * 768 * 256, p.q_norm_w + l * 256, 256, 768, kt * 64, nt * 64}; }
  else if (r < 784) { int rr = r - 752, kt = rr / 16, nt = rr % 16; j = TrJob{p.w_ukv + (size_t)l * 128 * 1024, (bfraw*)(p.ws + WS_WUKV) + (size_t)l * 1024 * 128, p.kv_norm_w + l * 128, 128, 1024, kt * 64, nt * 64}; }
  else if (r < 800) { int rr = r - 784, kt = rr / 4, nt = rr % 4; j = TrJob{p.cf_pw_w + (size_t)l * 256 * 256, (bfraw*)(p.ws + WS_WPW) + (size_t)l * 256 * 256, nullptr, 256, 256, kt * 64, nt * 64}; }
  else { int rr = r - 800, kt = rr / 16, nt = rr % 16; j = TrJob{p.w_out + (size_t)l * DM * DM, (bfraw*)(p.ws + WS_WOUT) + (size_t)l * DM * DM, nullptr, DM, DM, kt * 64, nt * 64}; }
  return j;
}
DI void tr_load(const TrJob& j, f32x4 (&v)[2]) {
  const int tid = TIDX();
#pragma unroll
  for (int i = 0; i < 2; ++i) {
    const int r = (tid >> 4) + i * 32, c = (tid & 15) * 4, n = j.n0 + c;
    v[i] = f32x4{0.f, 0.f, 0.f, 0.f};
    if (n < j.N) v[i] = *(const f32x4*)(j.src + (size_t)(j.k0 + r) * j.N + n);
    if (j.scale) { const float s = j.scale[j.k0 + r]; v[i] *= s; }
  }
}
DI void tr_lds(const f32x4 (&v)[2], float* tile) {
  const int tid = TIDX();
#pragma unroll
  for (int i = 0; i < 2; ++i) { const int r = (tid >> 4) + i * 32, c = (tid & 15) * 4; float* tp = tile + r * 65 + c; tp[0] = v[i][0]; tp[1] = v[i][1]; tp[2] = v[i][2]; tp[3] = v[i][3]; }
}
DI void tr_store(const TrJob& j, const float* tile) {
  const int tid = TIDX(), n = tid >> 3, k8 = (tid & 7) * 8;
  const float* tp = tile + k8 * 65 + n;
  u32x4 w = {cvtpk(tp[0], tp[65]), cvtpk(tp[130], tp[195]), cvtpk(tp[260], tp[325]), cvtpk(tp[390], tp[455])};
  *(u32x4*)(j.dst + (size_t)(j.n0 + n) * j.K + j.k0 + k8) = w;
}

DI void p0_prologue(const Params& p, char* lds) {
  const int tid = TIDX();
  constexpr int PER_L = 1056, NTR = DEPTH * PER_L, NMOD = DEPTH * 96;
  constexpr int TS = 64 * 65;
  const int G = gridDim.x;
  for (int it0 = blockIdx.x; it0 < NTR; it0 += 4 * G) {
    TrJob j0 = tr_decode(p, it0), j1 = j0, j2 = j0, j3 = j0;
    const bool h1 = it0 + G < NTR, h2 = it0 + 2 * G < NTR, h3 = it0 + 3 * G < NTR;
    if (h1) j1 = tr_decode(p, it0 + G); if (h2) j2 = tr_decode(p, it0 + 2 * G); if (h3) j3 = tr_decode(p, it0 + 3 * G);
    f32x4 v0[2], v1[2], v2[2], v3[2];
    tr_load(j0, v0); if (h1) tr_load(j1, v1); if (h2) tr_load(j2, v2); if (h3) tr_load(j3, v3);
    float* tile = (float*)lds;
    tr_lds(v0, tile); if (h1) tr_lds(v1, tile + TS); if (h2) tr_lds(v2, tile + 2 * TS); if (h3) tr_lds(v3, tile + 3 * TS);
    __syncthreads();
    tr_store(j0, tile); if (h1) tr_store(j1, tile + TS); if (h2) tr_store(j2, tile + 2 * TS); if (h3) tr_store(j3, tile + 3 * TS);
    __syncthreads();
  }
  for (int it = NTR + (int)((blockIdx.x + 64) % gridDim.x); it < NTR + NMOD; it += gridDim.x) {
    {
      const int m = it - NTR, l = m / 96, j0 = (m % 96) * 32;
      float* sl = (float*)lds;
      float* red = sl + 5 * 1024;
      for (int idx = tid; idx < 5 * 1024; idx += NTHR) {
        int r = idx >> 10, k = idx & 1023; float v = (r < 4) ? p.c[r * 1024 + k] : p.c_ctx[k]; sl[idx] = silu_f(v);
      }
      __syncthreads();
      const int col = tid & 31, kg = tid >> 5;
      float a0 = 0, a1 = 0, a2 = 0, a3 = 0, a4 = 0;
      const float* wm = p.w_mod + ((size_t)l * 1024 + kg * 64) * 3072 + j0 + col;
#pragma unroll 16
      for (int kk = 0; kk < 64; ++kk) {
        float w = wm[(size_t)kk * 3072]; int k = kg * 64 + kk;
        a0 += sl[k] * w; a1 += sl[1024 + k] * w; a2 += sl[2048 + k] * w; a3 += sl[3072 + k] * w; a4 += sl[4096 + k] * w;
      }
      red[(kg * 5 + 0) * 32 + col] = a0; red[(kg * 5 + 1) * 32 + col] = a1; red[(kg * 5 + 2) * 32 + col] = a2;
      red[(kg * 5 + 3) * 32 + col] = a3; red[(kg * 5 + 4) * 32 + col] = a4;
      __syncthreads();
      if (tid < 160) {
        int r = tid >> 5, cc = tid & 31; float s = p.b_mod[l * 3072 + j0 + cc];
        for (int g = 0; g < 16; ++g) s += red[(g * 5 + r) * 32 + cc];
        ((float*)(p.ws + WS_MOD))[(l * 5 + r) * 3072 + j0 + cc] = s;
      }
      __syncthreads();
    }
  }
}

DI void pa_norm(const Params& p, int l) {
  const int lane = TIDX() & 63, wid = TIDX() >> 6;
  const float* xl = (l == 0) ? p.x : p.out;
  const float* xc = (l == 0) ? p.ctx : (const float*)(p.ws + WS_XC1);
  const float* mod = (const float*)(p.ws + WS_MOD) + (size_t)l * 5 * 3072;
  const float* nw = p.norm_w + l * DM;
  bfraw* H = (bfraw*)(p.ws + WS_H);
  for (int row = blockIdx.x * 8 + wid; row < NTOK; row += gridDim.x * 8) {
    int b, pos; bool lat; row_info(row, b, lat, pos);
    const float* src = lat ? xl + (size_t)row * DM : xc + (size_t)(row - NLAT) * DM;
    const float* mr = mod + (lat ? b : 4) * 3072;
    f32x4 v[4]; float ss = 0.f;
#pragma unroll
    for (int i = 0; i < 4; ++i) { v[i] = *(const f32x4*)(src + i * 256 + lane * 4); ss += v[i][0] * v[i][0] + v[i][1] * v[i][1] + v[i][2] * v[i][2] + v[i][3] * v[i][3]; }
#pragma unroll
    for (int o = 32; o >= 1; o >>= 1) ss += __shfl_xor(ss, o);
    const float r = rsqrtf(ss * (1.f / DM) + EPS);
#pragma unroll
    for (int i = 0; i < 4; ++i) {
      const int k = i * 256 + lane * 4;
      f32x4 w = *(const f32x4*)(nw + k), sh = *(const f32x4*)(mr + k), sc = *(const f32x4*)(mr + 1024 + k);
      float h0 = v[i][0] * r * w[0] * (1.f + sc[0]) + sh[0], h1 = v[i][1] * r * w[1] * (1.f + sc[1]) + sh[1];
      float h2 = v[i][2] * r * w[2] * (1.f + sc[2]) + sh[2], h3 = v[i][3] * r * w[3] * (1.f + sc[3]) + sh[3];
      *(u32x2*)(H + (size_t)row * DM + k) = pack4(h0, h1, h2, h3);
    }
  }
}

constexpr int G_PITCH = 144, G_ABYTES = 128 * G_PITCH, G_BBYTES = 256 * G_PITCH, G_STAGE = G_ABYTES + G_BBYTES;
template <class Epi>
DI void gemm_tile(const bfraw* __restrict__ A, int lda, const bfraw* __restrict__ Bt, int ldb, int K, int m0, int n0, char* lds, Epi epi) {
  const int tid = TIDX(), lane = tid & 63, wid = tid >> 6, wm = wid >> 2, wn = wid & 3, l15 = lane & 15, quad = lane >> 4;
  f32x4 acc[4][4];
#pragma unroll
  for (int i = 0; i < 4; ++i)
#pragma unroll
    for (int j = 0; j < 4; ++j) acc[i][j] = f32x4{0.f, 0.f, 0.f, 0.f};
  const int srow = tid >> 3, skc = tid & 7;
  const bfraw* Ag = A + (size_t)(m0 + srow) * lda + skc * 8;
  const bfraw* Bg = Bt + (size_t)(n0 + srow) * ldb + skc * 8;
  bf16x8 ra0, ra1, rb0, rb1, rb2, rb3;
#define GLOAD(k0) do { ra0 = *(const bf16x8*)(Ag + (k0)); ra1 = *(const bf16x8*)(Ag + (size_t)64 * lda + (k0)); \
    rb0 = *(const bf16x8*)(Bg + (k0)); rb1 = *(const bf16x8*)(Bg + (size_t)64 * ldb + (k0)); \
    rb2 = *(const bf16x8*)(Bg + (size_t)128 * ldb + (k0)); rb3 = *(const bf16x8*)(Bg + (size_t)192 * ldb + (k0)); } while (0)
#define SWRITE(s) do { char* _b = lds + (s) * G_STAGE + srow * G_PITCH + skc * 16; \
    *(bf16x8*)(_b) = ra0; *(bf16x8*)(_b + 64 * G_PITCH) = ra1; \
    *(bf16x8*)(_b + G_ABYTES) = rb0; *(bf16x8*)(_b + G_ABYTES + 64 * G_PITCH) = rb1; \
    *(bf16x8*)(_b + G_ABYTES + 128 * G_PITCH) = rb2; *(bf16x8*)(_b + G_ABYTES + 192 * G_PITCH) = rb3; } while (0)
  GLOAD(0); SWRITE(0); __syncthreads();
  const int nk = K >> 6;
  for (int kt = 0; kt < nk; ++kt) {
    if (kt + 1 < nk) GLOAD((kt + 1) * 64);
    const char* base = lds + (kt & 1) * G_STAGE;
    const char* ap = base + (wm * 64 + l15) * G_PITCH + quad * 16;
    const char* bp = base + G_ABYTES + (wn * 64 + l15) * G_PITCH + quad * 16;
#pragma unroll
    for (int ks = 0; ks < 2; ++ks) {
      bf16x8 af[4], bfr[4];
#pragma unroll
      for (int mi = 0; mi < 4; ++mi) af[mi] = *(const bf16x8*)(ap + mi * 16 * G_PITCH + ks * 64);
#pragma unroll
      for (int ni = 0; ni < 4; ++ni) bfr[ni] = *(const bf16x8*)(bp + ni * 16 * G_PITCH + ks * 64);
#pragma unroll
      for (int ni = 0; ni < 4; ++ni)
#pragma unroll
        for (int mi = 0; mi < 4; ++mi) acc[ni][mi] = mfma16(bfr[ni], af[mi], acc[ni][mi]);
    }
    if (kt + 1 < nk) SWRITE((kt + 1) & 1);
    __syncthreads();
  }
#undef GLOAD
#undef SWRITE
#pragma unroll
  for (int ni = 0; ni < 4; ++ni)
#pragma unroll
    for (int mi = 0; mi < 4; ++mi) epi(m0 + wm * 64 + mi * 16 + l15, n0 + wn * 64 + ni * 16 + quad * 4, acc[ni][mi]);
}

#include <hip/hip_runtime.h>
namespace pg8 {
#define PG8_LAS __attribute__((address_space(3)))
typedef unsigned short bf16_t;
typedef short bf16x8 __attribute__((ext_vector_type(8)));
typedef float f32x4 __attribute__((ext_vector_type(4)));
typedef unsigned u32x4 __attribute__((ext_vector_type(4)));
constexpr int BM = 256, BK = 64, HALF = 128, HTB = HALF * BK * 2  , STAGE_BYTES = 8 * HTB, NXCD = 8, WGM = 8;

__host__ __device__ __forceinline__ int lds_byte(int r, int c) { const int st = (r >> 4) * 2 + (c >> 5), rr = r & 15, cc = c & 31, ob = rr * 64 + cc * 2; return st * 1024 + (ob ^ (((ob >> 9) & 1) << 5)); }
__host__ __device__ __forceinline__ void stage_rc(int b, int& R, int& C) { const int st = b / 1024, sb = b % 1024, swz = sb ^ (((sb >> 9) & 1) << 5); R = (st >> 1) * 16 + swz / 64; C = (st & 1) * 32 + (swz % 64) / 2; }
__host__ __device__ __forceinline__ int perm32(int rho) { const int n = rho >> 4, i = rho & 15; return 8 * (i >> 2) + 4 * n + (i & 3); }

struct Unit { int pm, pn; };
struct Gemm { const bf16_t* A; const bf16_t* Bt; int M, N, K; };

struct StaticOrder {
    int nM, nN, nwg, G, c;
    __host__ __device__ void init(int M, int N, int G_, int c_) { nM = M / BM; nN = N / BM; nwg = nM * nN; G = G_; c = c_; }
    __host__ __device__ bool next(int i, Unit& u) const {
        const long L = (long)i * G + c; if (L >= nwg) return false;
        int wgid = (int)L; { const int q = nwg / NXCD, r = nwg % NXCD, xcd = wgid % NXCD, off = wgid / NXCD; wgid = (xcd < r ? xcd * (q + 1) : r * (q + 1) + (xcd - r) * q) + off; }
        const int nig = WGM * nN, gid = wgid / nig, fm = gid * WGM, gsz = (nM - fm) < WGM ? (nM - fm) : WGM;
        u.pm = fm + ((wgid % nig) % gsz); u.pn = (wgid % nig) / gsz; return true;
    }
    __device__ __forceinline__ void a_ready(const Unit&) const {}
    __device__ __forceinline__ void done(const Unit&) const {}
};
template <class Epi, class Sched, bool STAMP = false>
__device__ __forceinline__ void gemm_phase(PG8_LAS unsigned char* lds, const Gemm g, const Sched& S, const Epi& E, unsigned long long* stamps) {
    const int tid = TIDX(), wid = __builtin_amdgcn_readfirstlane(tid >> 6), lane = tid & 63, wr = wid >> 2, wc = wid & 3, fr = lane & 15, fq = lane >> 4;
    const int K = g.K, nt = K / BK;
    int ts_lo = 0, ts_hi = 0, nts = 0; const unsigned long long rt_entry = STAMP ? (unsigned long long)wall_clock64() : 0ull;
#define PG8_STAMP() do { if (STAMP && wid == 0 && nts < 64) { const unsigned long long _c = (unsigned long long)clock64(); \
        ts_lo = (lane == nts) ? (int)(unsigned)_c : ts_lo; ts_hi = (lane == nts) ? (int)(unsigned)(_c >> 32) : ts_hi; ++nts; } } while (0)
    PG8_STAMP();
    unsigned voffA[2], voffB[2];
#pragma unroll
    for (int i = 0; i < 2; ++i) { int R, C; stage_rc(tid * 16 + i * 8192, R, C); const int Rb = Epi::PERM ? ((R & ~31) + perm32(R & 31)) : R;
        voffA[i] = (unsigned)(R * K + C) * 2u; voffB[i] = (unsigned)(Rb * K + C) * 2u; }
    const size_t kstep = (size_t)(BK * 2);
    const size_t hstep = (size_t)HALF * K * 2;
    const size_t tstep = 2 * hstep;
    const unsigned ldsw = (unsigned)wid * 1024u;
    const int aoff = lds_byte(wr * 64 + fr, fq * 8), boff = lds_byte(wc * 32 + fr, fq * 8);
#define PG8_SA(b, h) (((b) * 2 + (h)) * HTB)
#define PG8_SB(b, h) ((4 + (b) * 2 + (h)) * HTB)
#define PG8_STAGE(bufoff, gbase, voff) do { _Pragma("unroll") for (int _i = 0; _i < 2; ++_i) \
        __builtin_amdgcn_global_load_lds((const unsigned*)((const char*)(gbase) + (voff)[_i]), (PG8_LAS unsigned*)(lds + (bufoff) + ldsw + _i * 8192), 16, 0, 0); } while (0)
#define PG8_LDA(dst, b, h) do { _Pragma("unroll") for (int m = 0; m < 4; ++m) _Pragma("unroll") for (int k = 0; k < 2; ++k) dst[m][k] = *(const PG8_LAS bf16x8*)(lds + PG8_SA(b, h) + aoff + m * 2048 + k * 1024); } while (0)
#define PG8_LDB(dst, b, h) do { _Pragma("unroll") for (int n = 0; n < 2; ++n) _Pragma("unroll") for (int k = 0; k < 2; ++k) dst[n][k] = *(const PG8_LAS bf16x8*)(lds + PG8_SB(b, h) + boff + n * 2048 + k * 1024); } while (0)
#define PG8_MMA(ai, bj, At, Bt) do { __builtin_amdgcn_s_setprio(1); _Pragma("unroll") for (int m = 0; m < 4; ++m) _Pragma("unroll") for (int n = 0; n < 2; ++n) _Pragma("unroll") for (int k = 0; k < 2; ++k) \
        acc[ai][bj][m][n] = __builtin_amdgcn_mfma_f32_16x16x32_bf16(Bt[n][k], At[m][k], acc[ai][bj][m][n], 0, 0, 0); __builtin_amdgcn_s_setprio(0); } while (0)
#define PG8_WAIT_V(n) asm volatile("s_waitcnt vmcnt(" #n ")" ::: "memory")
#define PG8_WAIT_L(n) asm volatile("s_waitcnt lgkmcnt(" #n ")" ::: "memory")
#define PG8_BAR __builtin_amdgcn_s_barrier()
#define PG8_SCHED __builtin_amdgcn_sched_barrier(0)
    Unit cur, nxt; int ui = 0;
    if (!S.next(0, cur)) return;
    f32x4 acc[2][2][4][2];
#pragma unroll
    for (int a = 0; a < 2; ++a)
#pragma unroll
        for (int b = 0; b < 2; ++b)
#pragma unroll
            for (int m = 0; m < 4; ++m)
#pragma unroll
                for (int n = 0; n < 2; ++n) acc[a][b][m][n] = (f32x4){0.f, 0.f, 0.f, 0.f};
    bf16x8 At[4][2], B0[2][2], B1[2][2];
    const char* cA = (const char*)g.A + (size_t)cur.pm * tstep; const char* cB = (const char*)g.Bt + (size_t)cur.pn * tstep;
    S.a_ready(cur);
    PG8_STAGE(PG8_SB(0, 0), cB, voffB); PG8_STAGE(PG8_SA(0, 0), cA, voffA); PG8_STAGE(PG8_SB(0, 1), cB + hstep, voffB); PG8_STAGE(PG8_SA(0, 1), cA + hstep, voffA);
    if (wr == 1) PG8_BAR;
    PG8_WAIT_V(4); PG8_BAR;
    PG8_STAGE(PG8_SB(1, 0), cB + kstep, voffB); PG8_STAGE(PG8_SA(1, 0), cA + kstep, voffA); PG8_STAGE(PG8_SB(1, 1), cB + hstep + kstep, voffB);
    PG8_WAIT_V(6); PG8_BAR;
    PG8_STAMP();
    for (;;) {
        const bool has_next = S.next(ui + 1, nxt);
        const char* nA = has_next ? (const char*)g.A + (size_t)nxt.pm * tstep : cA; const char* nB = has_next ? (const char*)g.Bt + (size_t)nxt.pn * tstep : cB;
        for (int t = 0; t < nt; t += 2) {
            const bool last = (t == nt - 2);
            const char* a1 = cA + (size_t)(t + 1) * kstep;
            const char* a2 = last ? nA : cA + (size_t)(t + 2) * kstep; const char* b2 = last ? nB : cB + (size_t)(t + 2) * kstep;
            const char* a3 = a2 + kstep; const char* b3 = b2 + kstep;
            if (last && has_next) S.a_ready(nxt);
            PG8_LDB(B0, 0, 0); PG8_SCHED; PG8_LDA(At, 0, 0); PG8_STAGE(PG8_SA(1, 1), a1 + hstep, voffA);
            PG8_WAIT_L(8); PG8_BAR; PG8_WAIT_L(0); PG8_MMA(0, 0, At, B0); PG8_BAR; PG8_SCHED;
            PG8_LDB(B1, 0, 1); PG8_STAGE(PG8_SB(0, 0), b2, voffB);
            PG8_BAR; PG8_WAIT_L(0); PG8_MMA(0, 1, At, B1); PG8_BAR;
            PG8_LDA(At, 0, 1); PG8_STAGE(PG8_SA(0, 0), a2, voffA);
            PG8_BAR; PG8_WAIT_L(0); PG8_MMA(1, 0, At, B0); PG8_BAR; PG8_SCHED;
            PG8_STAGE(PG8_SB(0, 1), b2 + hstep, voffB);
            PG8_WAIT_V(6); PG8_BAR; PG8_MMA(1, 1, At, B1); PG8_BAR;
            PG8_LDB(B0, 1, 0); PG8_SCHED; PG8_LDA(At, 1, 0); PG8_STAGE(PG8_SA(0, 1), a2 + hstep, voffA);
            PG8_WAIT_L(8); PG8_BAR; PG8_WAIT_L(0); PG8_MMA(0, 0, At, B0); PG8_BAR; PG8_SCHED;
            PG8_LDB(B1, 1, 1); PG8_STAGE(PG8_SB(1, 0), b3, voffB);
            PG8_BAR; PG8_WAIT_L(0); PG8_MMA(0, 1, At, B1); PG8_BAR;
            PG8_LDA(At, 1, 1); PG8_STAGE(PG8_SA(1, 0), a3, voffA);
            PG8_BAR; PG8_WAIT_L(0); PG8_MMA(1, 0, At, B0); PG8_BAR; PG8_SCHED;
            PG8_STAGE(PG8_SB(1, 1), b3 + hstep, voffB);
            PG8_WAIT_V(6); PG8_BAR; PG8_MMA(1, 1, At, B1); PG8_BAR;
        }
        PG8_STAMP();
        if constexpr (!Epi::AFTER_DRAIN) { E(acc, cur, wr, wc, fr, fq); S.done(cur); }
        PG8_STAMP();
        if (!has_next) break;
#pragma unroll
        for (int a = 0; a < 2; ++a)
#pragma unroll
            for (int b = 0; b < 2; ++b)
#pragma unroll
                for (int m = 0; m < 4; ++m)
#pragma unroll
                    for (int n = 0; n < 2; ++n) acc[a][b][m][n] = (f32x4){0.f, 0.f, 0.f, 0.f};
        cur = nxt; cA = nA; cB = nB; ++ui;
    }
    PG8_WAIT_V(0);
    if (wr == 0) PG8_BAR;
    PG8_BAR;
    if constexpr (Epi::AFTER_DRAIN) { E.fused(acc, cur, wr, wc, fr, fq, lds, wid, lane); S.done(cur); }
    PG8_STAMP();
    if (STAMP && wid == 0) { stamps[lane] = lane < nts ? (((unsigned long long)(unsigned)ts_hi << 32) | (unsigned)ts_lo) : 0ull;
        if (lane == 62) stamps[62] = rt_entry; if (lane == 63) stamps[63] = (unsigned long long)wall_clock64(); }
#undef PG8_STAMP
#undef PG8_SA
#undef PG8_SB
#undef PG8_STAGE
#undef PG8_LDA
#undef PG8_LDB
#undef PG8_MMA
#undef PG8_WAIT_V
#undef PG8_WAIT_L
#undef PG8_BAR
#undef PG8_SCHED
}
}

struct EpiU {
  static constexpr bool PERM = true, AFTER_DRAIN = false;
  bfraw* U;
  __device__ __forceinline__ void operator()(const pg8::f32x4 (&acc)[2][2][4][2], const pg8::Unit& u, int wr, int wc, int fr, int fq) const {
    const int row0 = u.pm * 256 + wr * 64 + fr, col0 = u.pn * 256 + wc * 32 + 8 * fq;
#pragma unroll
    for (int ai = 0; ai < 2; ++ai)
#pragma unroll
      for (int m = 0; m < 4; ++m) { bfraw* rowp = U + (size_t)(row0 + ai * 128 + m * 16) * DIN + col0;
#pragma unroll
        for (int bj = 0; bj < 2; ++bj) { if (col0 + bj * 128 < DIN) { const pg8::f32x4 v0 = acc[ai][bj][m][0], v1 = acc[ai][bj][m][1];
          u32x4 w = {cvtpk(v0[0], v0[1]), cvtpk(v0[2], v0[3]), cvtpk(v1[0], v1[1]), cvtpk(v1[2], v1[3])};
          *(u32x4*)(rowp + bj * 128) = w; } } }
  }
};
struct EpiRes {
  static constexpr bool PERM = false, AFTER_DRAIN = false;
  const float* xres; float* out; const float* gate;
  __device__ __forceinline__ void operator()(const pg8::f32x4 (&acc)[2][2][4][2], const pg8::Unit& u, int wr, int wc, int fr, int fq) const {
    const int row0 = u.pm * 256 + wr * 64 + fr, col0 = u.pn * 256 + wc * 32 + 4 * fq;
    const float* g = gate + (size_t)((u.pm * 256) >> 13) * 3072 + col0;
    pg8::f32x4 gv[2][2];
#pragma unroll
    for (int bj = 0; bj < 2; ++bj)
#pragma unroll
      for (int n = 0; n < 2; ++n) gv[bj][n] = *(const pg8::f32x4*)(g + bj * 128 + n * 16);
#pragma unroll
    for (int ai = 0; ai < 2; ++ai)
#pragma unroll
      for (int m = 0; m < 4; ++m) { const size_t ro = (size_t)(row0 + ai * 128 + m * 16) * DM + col0;
#pragma unroll
        for (int bj = 0; bj < 2; ++bj)
#pragma unroll
          for (int n = 0; n < 2; ++n) { const pg8::f32x4 xr = *(const pg8::f32x4*)(xres + ro + bj * 128 + n * 16);
            *(pg8::f32x4*)(out + ro + bj * 128 + n * 16) = xr + gv[bj][n] * acc[ai][bj][m][n]; } }
  }
};

DI void pb_inproj(const Params& p, int l, char* lds) {
  pg8::Gemm g{(const bfraw*)(p.ws + WS_H), (const bfraw*)(p.ws + WS_WIN) + (size_t)l * DINP * DM, NTOK, DINP, DM};
  pg8::StaticOrder S; S.init(NTOK, DINP, (int)gridDim.x, (int)blockIdx.x);
  EpiU E{(bfraw*)(p.ws + WS_U)};
  pg8::gemm_phase<EpiU, pg8::StaticOrder, false>((PG8_LAS unsigned char*)lds, g, S, E, nullptr);
}

DI void pe_outproj(const Params& p, int l, char* lds) {
  const bfraw* Y = (const bfraw*)(p.ws + WS_H);
  const bfraw* W = (const bfraw*)(p.ws + WS_WOUT) + (size_t)l * DM * DM;
  const float* mod = (const float*)(p.ws + WS_MOD) + (size_t)l * 5 * 3072 + 2048;
  {
    pg8::Gemm g{Y, W, NLAT, DM, DM};
    pg8::StaticOrder S; S.init(NLAT, DM, (int)gridDim.x, (int)blockIdx.x);
    EpiRes E{(l == 0) ? p.x : p.out, p.out, mod};
    pg8::gemm_phase<EpiRes, pg8::StaticOrder, false>((PG8_LAS unsigned char*)lds, g, S, E, nullptr);
  }
  if (l < DEPTH - 1) {
    const float* xc = p.ctx; float* oc = (float*)(p.ws + WS_XC1);
    constexpr int NT = (NCTX / 128) * 4;
    for (int t = (int)gridDim.x - 1 - (int)blockIdx.x; t < NT; t += gridDim.x) {
      const int mt = t >> 2, nt = t & 3;
      gemm_tile(Y, DM, W, DM, DM, NLAT + mt * 128, nt * 256, lds, [&](int m, int n, f32x4 v) {
        const f32x4 gg = *(const f32x4*)(mod + 4 * 3072 + n);
        const size_t o = (size_t)(m - NLAT) * DM + n;
        const f32x4 xr = *(const f32x4*)(xc + o);
        *(f32x4*)(oc + o) = xr + gg * v;
      });
    }
  }
}

DI void rows_rms(const char* tile, int pitchB, int nchunk_per_lane, float inv_n, float* out) {
  const int lane = TIDX() & 63, wid = TIDX() >> 6;
  const int row = wid * 8 + (lane >> 3), part = lane & 7;
  float ss = 0.f;
  for (int i = 0; i < nchunk_per_lane; ++i) {
    bf16x8 v = *(const bf16x8*)(tile + row * pitchB + (part + i * 8) * 16);
#pragma unroll
    for (int j = 0; j < 8; ++j) { float f = bf2f(v[j]); ss += f * f; }
  }
  ss += __shfl_xor(ss, 4); ss += __shfl_xor(ss, 2); ss += __shfl_xor(ss, 1);
  if (part == 0) out[row] = rsqrtf(ss * inv_n + EPS);
}

DI void rope_cs(int pos, int d, float& c, float& s) {
  const float pp = (float)((d < 8) ? (pos >> 6) : (pos & 63));
  const float inv = exp2f(-(float)(d & 7) * 1.6609640474436813f);
  const float ang = pp * inv;
  c = __cosf(ang); s = __sinf(ang);
}

template <int NC> DI void wave_tile_flush(const char* st, bfraw* gdst) {
  const int lane = TIDX() & 63;
  constexpr int CPR = NC / 8, NCH = 64 * CPR, PITCH = NC * 2 + 16;
  asm volatile("s_waitcnt lgkmcnt(0)" ::: "memory");
#pragma unroll
  for (int c = lane; c < NCH; c += 64) { const int row = c / CPR, cc = c % CPR;
    *(bf16x8*)(gdst + (size_t)c * 8) = *(const bf16x8*)(st + row * PITCH + cc * 16); }
  asm volatile("s_waitcnt lgkmcnt(0)" ::: "memory");
}
DI void pc_q(const Params& p, int l, char* lds) {
  const int tid = TIDX(), lane = tid & 63, h = tid >> 6, l15 = lane & 15, quad = lane >> 4;
  constexpr int PB_ = 528;
  char* At = lds; float* rq = (float*)(lds + 64 * PB_);
  char* stq = lds + 35 * 1024 + h * (64 * 208);
  const bfraw* U = (const bfraw*)(p.ws + WS_U);
  const bfraw* W = (const bfraw*)(p.ws + WS_WUQ) + (size_t)l * 768 * 256;
  bfraw* Q = (bfraw*)(p.ws + WS_Q);
  const float* wh = p.q_head_norm_w + l * DQK;
  const int ntile = ((l == DEPTH - 1) ? NLAT : NTOK) / 64;
  const bfraw* Wp = W + (size_t)(h * 96 + l15) * 256 + quad * 8;
  bf16x8 ra[4];
  if ((int)blockIdx.x < ntile) {
#pragma unroll
    for (int i = 0; i < 4; ++i) { int c = tid + i * NTHR, row = c >> 5, kc = c & 31;
      ra[i] = *(const bf16x8*)(U + (size_t)((int)blockIdx.x * 64 + row) * DIN + U_CQ + kc * 8); }
  }
  for (int t = blockIdx.x; t < ntile; t += gridDim.x) {
    const int m0 = t * 64;
    const bfraw* Wpt = Wp; asm volatile("" : "+v"(Wpt));
    bf16x8 bw[2][6];
#pragma unroll
    for (int s = 0; s < 2; ++s)
#pragma unroll
      for (int ni = 0; ni < 6; ++ni) bw[s][ni] = *(const bf16x8*)(Wpt + ni * 16 * 256 + s * 32);
#pragma unroll
    for (int i = 0; i < 4; ++i) { int c = tid + i * NTHR, row = c >> 5, kc = c & 31; *(bf16x8*)(At + row * PB_ + kc * 16) = ra[i]; }
    if (t + (int)gridDim.x < ntile) {
#pragma unroll
      for (int i = 0; i < 4; ++i) { int c = tid + i * NTHR, row = c >> 5, kc = c & 31;
        ra[i] = *(const bf16x8*)(U + (size_t)(m0 + (int)gridDim.x * 64 + row) * DIN + U_CQ + kc * 8); }
    }
    __syncthreads();
    rows_rms(At, PB_, 4, 1.f / 256.f, rq);
    __syncthreads();
    f32x4 acc[6][4];
#pragma unroll
    for (int i = 0; i < 6; ++i)
#pragma unroll
      for (int j = 0; j < 4; ++j) acc[i][j] = f32x4{0.f, 0.f, 0.f, 0.f};
    const char* ap = At + l15 * PB_ + quad * 16;
#pragma unroll
    for (int ks = 0; ks < 8; ++ks) {
      bf16x8 af[4];
#pragma unroll
      for (int mi = 0; mi < 4; ++mi) af[mi] = *(const bf16x8*)(ap + mi * 16 * PB_ + ks * 64);
#pragma unroll
      for (int ni = 0; ni < 6; ++ni)
#pragma unroll
        for (int mi = 0; mi < 4; ++mi) acc[ni][mi] = mfma16(bw[ks & 1][ni], af[mi], acc[ni][mi]);
      if (ks + 2 < 8) {
#pragma unroll
        for (int ni = 0; ni < 6; ++ni) bw[ks & 1][ni] = *(const bf16x8*)(Wpt + ni * 16 * 256 + (ks + 2) * 32);
      }
      SBAR();
    }
    float whv[6][4];
#pragma unroll
    for (int ni = 0; ni < 6; ++ni)
#pragma unroll
      for (int j = 0; j < 4; ++j) whv[ni][j] = wh[ni * 16 + quad * 4 + j];
#pragma unroll
    for (int mi = 0; mi < 4; ++mi) {
      const int row = m0 + mi * 16 + l15; int b, pos; bool lat; row_info(row, b, lat, pos);
      const float r = rq[mi * 16 + l15];
      float ss = 0.f;
#pragma unroll
      for (int ni = 0; ni < 6; ++ni)
#pragma unroll
        for (int j = 0; j < 4; ++j) { float y = acc[ni][mi][j] * r; ss += y * y; }
      ss += __shfl_xor(ss, 16); ss += __shfl_xor(ss, 32);
      const float f = r * rsqrtf(ss * (1.f / DQK) + EPS) * QSCALE;
      float val[6][4];
#pragma unroll
      for (int ni = 0; ni < 6; ++ni)
#pragma unroll
        for (int j = 0; j < 4; ++j) val[ni][j] = acc[ni][mi][j] * f * whv[ni][j];
      if (lat) {
#pragma unroll
        for (int j = 0; j < 4; ++j) { float c, s; rope_cs(pos, quad * 4 + j, c, s);
          float x1 = val[4][j], x2 = val[5][j]; val[4][j] = x1 * c - x2 * s; val[5][j] = x2 * c + x1 * s; }
      }
      char* qs = stq + (mi * 16 + l15) * 208 + quad * 8;
#pragma unroll
      for (int ni = 0; ni < 6; ++ni) *(u32x2*)(qs + ni * 32) = pack4(val[ni][0], val[ni][1], val[ni][2], val[ni][3]);
    }
    { int b0, pos0; bool lat0; row_info(m0, b0, lat0, pos0);
      wave_tile_flush<96>(stq, Q + ((size_t)(b0 * NH + h) * NKEY + (lat0 ? CLEN + pos0 : pos0)) * DQK); }
    __syncthreads();
  }
}

DI void pc_kv(const Params& p, int l, char* lds) {
  const int tid = TIDX(), lane = tid & 63, h = tid >> 6, l15 = lane & 15, quad = lane >> 4;
  constexpr int PB_ = 336;
  char* At = lds; float* rkv = (float*)(lds + 64 * PB_);
  char* stk = lds + 35 * 1024 + h * (64 * 208);
  const bfraw* U = (const bfraw*)(p.ws + WS_U);
  const bfraw* W = (const bfraw*)(p.ws + WS_WUKV) + (size_t)l * 1024 * 128;
  bfraw* Kd = (bfraw*)(p.ws + WS_K); bfraw* Vd = (bfraw*)(p.ws + WS_V);
  const float* wh = p.k_head_norm_w + l * DQK;
  const int ntile = NTOK / 64;
  for (int t = (blockIdx.x + gridDim.x - (int)(gridDim.x / 3)) % gridDim.x; t < ntile; t += gridDim.x) {
    const int m0 = t * 64;
    const bfraw* Wpt = W + (size_t)(h * 128 + l15) * 128 + quad * 8; asm volatile("" : "+v"(Wpt));
    bf16x8 bw[4][4];
#pragma unroll
    for (int ks = 0; ks < 4; ++ks)
#pragma unroll
      for (int ni = 0; ni < 4; ++ni) bw[ks][ni] = *(const bf16x8*)(Wpt + ni * 16 * 128 + ks * 32);
    for (int c = tid; c < 64 * 20; c += NTHR) { int row = c / 20, kc = c % 20;
      *(bf16x8*)(At + row * PB_ + kc * 16) = *(const bf16x8*)(U + (size_t)(m0 + row) * DIN + U_CKV + kc * 8); }
    __syncthreads();
    rows_rms(At, PB_, 2, 1.f / 128.f, rkv);
    __syncthreads();
    const char* ap = At + l15 * PB_ + quad * 16;
#pragma unroll
    for (int pass = 0; pass < 2; ++pass) {
      f32x4 acc[4][4];
#pragma unroll
      for (int i = 0; i < 4; ++i)
#pragma unroll
        for (int j = 0; j < 4; ++j) acc[i][j] = f32x4{0.f, 0.f, 0.f, 0.f};
#pragma unroll
      for (int ks = 0; ks < 4; ++ks) {
        bf16x8 af[4];
#pragma unroll
        for (int mi = 0; mi < 4; ++mi) af[mi] = *(const bf16x8*)(ap + mi * 16 * PB_ + ks * 64);
#pragma unroll
        for (int ni = 0; ni < 4; ++ni)
#pragma unroll
          for (int mi = 0; mi < 4; ++mi) acc[ni][mi] = mfma16(bw[ks][ni], af[mi], acc[ni][mi]);
      }
      if (pass == 0) {
#pragma unroll
        for (int ks = 0; ks < 4; ++ks)
#pragma unroll
          for (int ni = 0; ni < 4; ++ni) bw[ks][ni] = *(const bf16x8*)(Wpt + (64 + ni * 16) * 128 + ks * 32);
      }
#pragma unroll
      for (int mi = 0; mi < 4; ++mi) {
        const int row = m0 + mi * 16 + l15; int b, pos; bool lat; row_info(row, b, lat, pos);
        const float r = rkv[mi * 16 + l15];
        const int key = lat ? CLEN + pos : pos;
        if (pass == 0) {
          const s16x4 k1 = *(const s16x4*)(At + (mi * 16 + l15) * PB_ + (128 + quad * 4) * 2);
          const s16x4 k2 = *(const s16x4*)(At + (mi * 16 + l15) * PB_ + (144 + quad * 4) * 2);
          float ss = 0.f;
#pragma unroll
          for (int ni = 0; ni < 4; ++ni)
#pragma unroll
            for (int j = 0; j < 4; ++j) { float y = acc[ni][mi][j] * r; ss += y * y; }
          float kr1[4], kr2[4];
#pragma unroll
          for (int j = 0; j < 4; ++j) { kr1[j] = bf2f(k1[j]); kr2[j] = bf2f(k2[j]); ss += kr1[j] * kr1[j] + kr2[j] * kr2[j]; }
          ss += __shfl_xor(ss, 16); ss += __shfl_xor(ss, 32);
          const float rinv = rsqrtf(ss * (1.f / DQK) + EPS);
          const float f = r * rinv;
          char* kd = stk + (mi * 16 + l15) * 208 + quad * 8;
#pragma unroll
          for (int ni = 0; ni < 4; ++ni) {
            const int n = ni * 16 + quad * 4;
            *(u32x2*)(kd + ni * 32) = pack4(acc[ni][mi][0] * f * wh[n], acc[ni][mi][1] * f * wh[n + 1], acc[ni][mi][2] * f * wh[n + 2], acc[ni][mi][3] * f * wh[n + 3]);
          }
          float x1[4], x2[4];
#pragma unroll
          for (int j = 0; j < 4; ++j) {
            const int d = quad * 4 + j;
            float a = kr1[j] * rinv * wh[64 + d], bb = kr2[j] * rinv * wh[80 + d];
            if (lat) { float c, s; rope_cs(pos, d, c, s); x1[j] = a * c - bb * s; x2[j] = bb * c + a * s; }
            else { x1[j] = a; x2[j] = bb; }
          }
          *(u32x2*)(kd + 128) = pack4(x1[0], x1[1], x1[2], x1[3]);
          *(u32x2*)(kd + 160) = pack4(x2[0], x2[1], x2[2], x2[3]);
        } else {
          char* vd = stk + (mi * 16 + l15) * 144 + quad * 8;
#pragma unroll
          for (int ni = 0; ni < 4; ++ni)
            *(u32x2*)(vd + ni * 32) = pack4(acc[ni][mi][0] * r, acc[ni][mi][1] * r, acc[ni][mi][2] * r, acc[ni][mi][3] * r);
        }
      }
      { int b0, pos0; bool lat0; row_info(m0, b0, lat0, pos0);
        const size_t key0 = (size_t)(b0 * NH + h) * NKEY + (lat0 ? CLEN + pos0 : pos0);
        if (pass == 0) wave_tile_flush<96>(stk, Kd + key0 * DQK); else wave_tile_flush<64>(stk, Vd + key0 * DV); }
    }
    __syncthreads();
  }
}

DI void pc_conv(const Params& p, int l, char* lds) {
  const int tid = TIDX(), lane = tid & 63, wid = tid >> 6, l15 = lane & 15, quad = lane >> 4;
  const bfraw* U = (const bfraw*)(p.ws + WS_U);
  bfraw* Y = (bfraw*)(p.ws + WS_H);
  const bfraw* Wpw = (const bfraw*)(p.ws + WS_WPW) + (size_t)l * 256 * 256;
  const float* scw = p.sc_conv_w + l * 3 * 256;
  const float* cfw = p.cf_conv_w + l * 31 * 256;
  const float* cfb = p.cf_conv_b + l * 256;
  const float* lnw = p.cf_ln_w + l * 256; const float* lnb = p.cf_ln_b + l * 256;
  const float* pwb = p.cf_pw_b + l * 256;
  bfraw* G = (bfraw*)lds;
  constexpr int APB = 528;
  float* Z = (float*)(lds + 48128);
  const int ntile = ((l == DEPTH - 1) ? NLAT : NTOK) / 64;
  bf16x8 wpw[8][2];
  {
    const bfraw* Wp = Wpw + (size_t)(wid * 32 + l15) * 256 + quad * 8;
#pragma unroll
    for (int ks = 0; ks < 8; ++ks)
#pragma unroll
      for (int ni = 0; ni < 2; ++ni) wpw[ks][ni] = *(const bf16x8*)(Wp + ni * 16 * 256 + ks * 32);
  }
  for (int t = (blockIdx.x + gridDim.x - (int)(2 * gridDim.x / 3)) % gridDim.x; t < ntile; t += gridDim.x) {
    const int tok0 = t * 64; int b, pos0; bool lat; row_info(tok0, b, lat, pos0);
    const int seq0 = tok0 - pos0, slen = lat ? TSEQ : CLEN;
#pragma unroll 2
    for (int i = 0; i < 4; ++i) {
      const int idx = tid + i * NTHR, tt = idx >> 5, c8 = (idx & 31) * 8, row = tok0 + tt, pos = pos0 + tt;
      const bfraw* ur = U + (size_t)row * DIN;
      bf16x8 ci = *(const bf16x8*)(ur + U_SCIN + c8), cc = *(const bf16x8*)(ur + U_SCC + c8);
      bf16x8 cb = *(const bf16x8*)(ur + U_SCB + c8), gb = *(const bf16x8*)(ur + U_GB + c8);
      bf16x8 pi = ci, pc = cc, ni_ = ci, nc = cc;
      const bool hp = pos > 0, hn = pos < slen - 1;
      if (hp) { pi = *(const bf16x8*)(ur - DIN + U_SCIN + c8); pc = *(const bf16x8*)(ur - DIN + U_SCC + c8); }
      if (hn) { ni_ = *(const bf16x8*)(ur + DIN + U_SCIN + c8); nc = *(const bf16x8*)(ur + DIN + U_SCC + c8); }
      float o[8];
#pragma unroll
      for (int j = 0; j < 8; ++j) {
        const int c = c8 + j;
        float pp = hp ? bf2f(pi[j]) * bf2f(pc[j]) : 0.f, pn = hn ? bf2f(ni_[j]) * bf2f(nc[j]) : 0.f, p0 = bf2f(ci[j]) * bf2f(cc[j]);
        float cv = scw[c] * pp + scw[256 + c] * p0 + scw[512 + c] * pn;
        o[j] = bf2f(cb[j]) * cv * silu_f(bf2f(gb[j]));
      }
      u32x4 w = {cvtpk(o[0], o[1]), cvtpk(o[2], o[3]), cvtpk(o[4], o[5]), cvtpk(o[6], o[7])};
      *(u32x4*)(Y + (size_t)row * DM + 512 + c8) = w;
    }
#pragma unroll 3
    for (int idx = tid; idx < 94 * 32; idx += NTHR) {
      const int rr = idx >> 5, c8 = (idx & 31) * 8, pos = pos0 - 15 + rr;
      u32x4 w = {0u, 0u, 0u, 0u};
      if (pos >= 0 && pos < slen) {
        const bfraw* ur = U + (size_t)(seq0 + pos) * DIN;
        bf16x8 a = *(const bf16x8*)(ur + U_CFA + c8), g = *(const bf16x8*)(ur + U_CFG + c8);
        float o[8];
#pragma unroll
        for (int j = 0; j < 8; ++j) o[j] = bf2f(a[j]) * sigmoid_f(bf2f(g[j]));
        w = u32x4{cvtpk(o[0], o[1]), cvtpk(o[2], o[3]), cvtpk(o[4], o[5]), cvtpk(o[6], o[7])};
      }
      *(u32x4*)(G + rr * 256 + c8) = w;
    }
    __syncthreads();
    {
      const int c = tid & 255, half = tid >> 8;
      float w[31];
#pragma unroll
      for (int k = 0; k < 31; ++k) w[k] = cfw[k * 256 + c];
      const float bias = cfb[c];
#pragma unroll 1
      for (int o0 = 0; o0 < 32; o0 += 4) {
        float a0 = bias, a1 = bias, a2 = bias, a3 = bias;
        const bfraw* gp = G + (half * 32 + o0) * 256 + c;
#pragma unroll
        for (int i = 0; i < 34; ++i) {
          const float v = bf2f((short)gp[i * 256]);
          if (i < 31) a0 += w[i] * v;
          if (i >= 1 && i < 32) a1 += w[i - 1] * v;
          if (i >= 2 && i < 33) a2 += w[i - 2] * v;
          if (i >= 3) a3 += w[i - 3] * v;
        }
        float* zp = Z + (half * 32 + o0) * 260 + c;
        zp[0] = a0; zp[260] = a1; zp[520] = a2; zp[780] = a3;
      }
    }
    __syncthreads();
    {
      f32x4 lw = *(const f32x4*)(lnw + lane * 4), lb = *(const f32x4*)(lnb + lane * 4);
#pragma unroll 1
      for (int i = 0; i < 8; ++i) {
        const int tt = wid * 8 + i;
        f32x4 z = *(const f32x4*)(Z + tt * 260 + lane * 4);
        float s = z[0] + z[1] + z[2] + z[3];
#pragma unroll
        for (int o = 32; o >= 1; o >>= 1) s += __shfl_xor(s, o);
        const float mu = s * (1.f / 256.f);
        float d0 = z[0] - mu, d1 = z[1] - mu, d2 = z[2] - mu, d3 = z[3] - mu;
        float q = d0 * d0 + d1 * d1 + d2 * d2 + d3 * d3;
#pragma unroll
        for (int o = 32; o >= 1; o >>= 1) q += __shfl_xor(q, o);
        const float rs = rsqrtf(q * (1.f / 256.f) + LN_EPS);
        float y0 = silu_f(d0 * rs * lw[0] + lb[0]), y1 = silu_f(d1 * rs * lw[1] + lb[1]);
        float y2 = silu_f(d2 * rs * lw[2] + lb[2]), y3 = silu_f(d3 * rs * lw[3] + lb[3]);
        *(u32x2*)((char*)G + tt * APB + lane * 8) = pack4(y0, y1, y2, y3);
      }
    }
    __syncthreads();
    {
      f32x4 acc[2][4];
#pragma unroll
      for (int i = 0; i < 2; ++i)
#pragma unroll
        for (int j = 0; j < 4; ++j) acc[i][j] = f32x4{0.f, 0.f, 0.f, 0.f};
      const char* ap = (const char*)G + l15 * APB + quad * 16;
#pragma unroll
      for (int ks = 0; ks < 8; ++ks) {
        bf16x8 af[4];
#pragma unroll
        for (int mi = 0; mi < 4; ++mi) af[mi] = *(const bf16x8*)(ap + mi * 16 * APB + ks * 64);
#pragma unroll
        for (int ni = 0; ni < 2; ++ni)
#pragma unroll
          for (int mi = 0; mi < 4; ++mi) acc[ni][mi] = mfma16(wpw[ks][ni], af[mi], acc[ni][mi]);
      }
#pragma unroll
      for (int ni = 0; ni < 2; ++ni) {
        const int n = wid * 32 + ni * 16 + quad * 4;
        const f32x4 pb = *(const f32x4*)(pwb + n);
#pragma unroll
        for (int mi = 0; mi < 4; ++mi) {
          const int row = tok0 + mi * 16 + l15;
          const s16x4 gc = *(const s16x4*)(U + (size_t)row * DIN + U_GC + n);
          float y0 = (acc[ni][mi][0] + pb[0]) * silu_f(bf2f(gc[0])), y1 = (acc[ni][mi][1] + pb[1]) * silu_f(bf2f(gc[1]));
          float y2 = (acc[ni][mi][2] + pb[2]) * silu_f(bf2f(gc[2])), y3 = (acc[ni][mi][3] + pb[3]) * silu_f(bf2f(gc[3]));
          *(u32x2*)(Y + (size_t)row * DM + 768 + n) = pack4(y0, y1, y2, y3);
        }
      }
    }
    __syncthreads();
  }
}

constexpr float ATT_SCALE = 0.10206207261596575f;
constexpr float ATT_THR = 8.f;
constexpr int SHM_V = 64 * 64 * 2, SHM_K = 64 * 256;
#define KSWZ(row, colB) ((row) * 256 + ((colB) ^ (((row) & 15) << 4)))
DI int crow(int r, int hi) { return (r & 3) + 8 * (r >> 2) + 4 * hi; }

template <bool FAST>
DI void partialSM(f32x16& p0, f32x16& p1, float& m_reg, float& mn, float& alpha) {
  if constexpr (!FAST) {
    float pmax = p0[0];
#pragma unroll
    for (int r = 1; r < 16; ++r) pmax = fmaxf(pmax, p0[r]);
#pragma unroll
    for (int r = 0; r < 16; ++r) pmax = fmaxf(pmax, p1[r]);
    { auto rr = __builtin_amdgcn_permlane32_swap(__float_as_uint(pmax), __float_as_uint(pmax), false, false);
      pmax = fmaxf(__uint_as_float(rr[0]), __uint_as_float(rr[1])); }
    if (__builtin_expect(__all(pmax - m_reg <= ATT_THR * 1.4426950408889634f), 1)) { mn = m_reg; alpha = 1.f; }
    else { mn = fmaxf(m_reg, pmax); alpha = __builtin_amdgcn_exp2f(m_reg - mn); m_reg = mn; }
#pragma unroll
    for (int r = 0; r < 16; ++r) p0[r] -= mn;
#pragma unroll
    for (int r = 0; r < 16; ++r) p1[r] -= mn;
  }
#pragma unroll
  for (int r = 0; r < 16; ++r) p0[r] = __builtin_amdgcn_exp2f(p0[r]);
}
template <bool FAST>
DI void finishSM(f32x16& p0, f32x16& p1, float alpha, float& l_reg, bf16x8& pa0, bf16x8& pa1, bf16x8& pa2, bf16x8& pa3) {
#pragma unroll
  for (int r = 0; r < 16; ++r) p1[r] = __builtin_amdgcn_exp2f(p1[r]);
  const f32x16 s16 = p0 + p1;
  using f32x8 = __attribute__((ext_vector_type(8))) float;
  using f32x2 = __attribute__((ext_vector_type(2))) float;
  const f32x8 s8 = __builtin_shufflevector(s16, s16, 0, 1, 2, 3, 4, 5, 6, 7) + __builtin_shufflevector(s16, s16, 8, 9, 10, 11, 12, 13, 14, 15);
  const f32x4 s4 = __builtin_shufflevector(s8, s8, 0, 1, 2, 3) + __builtin_shufflevector(s8, s8, 4, 5, 6, 7);
  const f32x2 s2 = __builtin_shufflevector(s4, s4, 0, 1) + __builtin_shufflevector(s4, s4, 2, 3);
  float ps = s2[0] + s2[1];
  if constexpr (FAST) { l_reg += ps; }
  else {
    auto rr = __builtin_amdgcn_permlane32_swap(__float_as_uint(ps), __float_as_uint(ps), false, false);
    ps = __uint_as_float(rr[0]) + __uint_as_float(rr[1]);
    l_reg = l_reg * alpha + ps;
  }
#define PK4(P, BASE, OUT) do { unsigned a0 = cvtpk(P[BASE + 0], P[BASE + 1]), a1 = cvtpk(P[BASE + 2], P[BASE + 3]);   \
    unsigned b0 = cvtpk(P[BASE + 4], P[BASE + 5]), b1 = cvtpk(P[BASE + 6], P[BASE + 7]);                              \
    auto r0 = __builtin_amdgcn_permlane32_swap(a0, b0, false, false); auto r1 = __builtin_amdgcn_permlane32_swap(a1, b1, false, false); \
    u32x4 w = {r0[0], r1[0], r0[1], r1[1]}; OUT = *reinterpret_cast<bf16x8*>(&w); } while (0)
  PK4(p0, 0, pa0); PK4(p0, 8, pa1); PK4(p1, 0, pa2); PK4(p1, 8, pa3);
#undef PK4
}
DI void qkt(f32x16& p0, f32x16& p1, const char* Ks, const bf16x8* qr, int r32, int hi) {
  p0 = f32x16{}; p1 = f32x16{};
#pragma unroll
  for (int d0 = 0; d0 < 6; ++d0) { int cb = (d0 * 16 + hi * 8) * 2;
    bf16x8 b0 = *reinterpret_cast<const bf16x8*>(Ks + KSWZ(r32, cb));
    bf16x8 b1 = *reinterpret_cast<const bf16x8*>(Ks + KSWZ(32 + r32, cb));
    p0 = __builtin_amdgcn_mfma_f32_32x32x16_bf16(b0, qr[d0], p0, 0, 0, 0);
    p1 = __builtin_amdgcn_mfma_f32_32x32x16_bf16(b1, qr[d0], p1, 0, 0, 0); }
}
DI int v_st(int k, int c) { const int kk = (k & ~0xC) | ((k & 4) << 1) | ((k & 8) >> 1); return ((kk >> 3) * 2 + (c >> 5)) * 512 + ((kk & 7) * 32 + (c & 31)) * 2; }
DI int v_st_acc(int k, int c) { return ((k >> 3) * 2 + (c >> 5)) * 512 + ((k & 7) * 32 + (c & 31)) * 2; }
DI int v_rd_base(int lane) { return ((lane & 3) << 3) | (((lane >> 2) & 3) << 6) | (((lane >> 4) & 1) << 5) | (((lane >> 5) & 1) << 8); }
constexpr int v_rd_off(int d0, int ks, int half) { return d0 * 512 + ks * 2048 + half * 1024; }
template <int OFF> DI s16x4 tr_read(int vb) {
  return __builtin_amdgcn_ds_read_tr16_b64_v4i16((__attribute__((address_space(3))) s16x4*)(unsigned)(vb + OFF));
}
template <int D0> DI void pv_one(f32x16& od, int vb, bf16x8 pa0, bf16x8 pa1, bf16x8 pa2, bf16x8 pa3) {
  const s16x4 l0 = tr_read<v_rd_off(D0, 0, 0)>(vb), h0 = tr_read<v_rd_off(D0, 0, 1)>(vb), l1 = tr_read<v_rd_off(D0, 1, 0)>(vb), h1 = tr_read<v_rd_off(D0, 1, 1)>(vb);
  const s16x4 l2 = tr_read<v_rd_off(D0, 2, 0)>(vb), h2 = tr_read<v_rd_off(D0, 2, 1)>(vb), l3 = tr_read<v_rd_off(D0, 3, 0)>(vb), h3 = tr_read<v_rd_off(D0, 3, 1)>(vb);
#define PK(L, H) (bf16x8){L[0], L[1], L[2], L[3], H[0], H[1], H[2], H[3]}
  od = __builtin_amdgcn_mfma_f32_32x32x16_bf16(pa0, PK(l0, h0), od, 0, 0, 0);
  od = __builtin_amdgcn_mfma_f32_32x32x16_bf16(pa1, PK(l1, h1), od, 0, 0, 0);
  od = __builtin_amdgcn_mfma_f32_32x32x16_bf16(pa2, PK(l2, h2), od, 0, 0, 0);
  od = __builtin_amdgcn_mfma_f32_32x32x16_bf16(pa3, PK(l3, h3), od, 0, 0, 0);
#undef PK
}
DI void pv_d0(f32x16* o, int vb, bf16x8 pa0, bf16x8 pa1, bf16x8 pa2, bf16x8 pa3) {
  pv_one<0>(o[0], vb, pa0, pa1, pa2, pa3); pv_one<1>(o[1], vb, pa0, pa1, pa2, pa3);
}

template <bool FAST>
DI void attn_body(const bfraw* __restrict__ Qb, const bfraw* __restrict__ Kh, const bfraw* __restrict__ Vh, int seq, char* lds,
                  const bfraw* __restrict__ U, bfraw* __restrict__ Y, int orow0, int h) {
  int tid_ = TIDX(); asm volatile("" : "+v"(tid_));
  const int tid = tid_, wid = __builtin_amdgcn_readfirstlane(tid >> 6), lane = tid & 63, r32 = lane & 31, hi = lane >> 5;
  char* V_lds = lds; char* K_lds = lds + 2 * SHM_V;
  float* ws = (float*)(lds + 2 * SHM_V + 2 * SHM_K) + wid * 64; float* li_l = ws; float* al_l = ws + 32;
  float m_reg = -1e30f, l_reg = 0; f32x16 o[2] = {}; bf16x8 qr[6];
  const bfraw* Qw = Qb + (size_t)(wid * 32 + r32) * DQK + hi * 8;
#pragma unroll
  for (int d0 = 0; d0 < 6; ++d0) qr[d0] = *(const bf16x8*)(Qw + d0 * 16);
  const int sr = tid >> 3, sc = (tid & 7) * 8;
  const int sr2 = (tid & 255) >> 2, sc2 = 64 + (tid & 3) * 8;
  const bool kx = wid < 4;
  const int vst = v_st(sr, sc), kst = KSWZ(sr, sc * 2), kst2 = KSWZ(sr2, sc2 * 2);
  const int vb0 = (int)(uintptr_t)V_lds + v_rd_base(lane);
  struct { bf16x8 vs, ks, ks2; } sr_[2];
  const unsigned voffg = (unsigned)(sr * DV + sc) * 2u, koffg = (unsigned)(sr * DQK + sc) * 2u, koffg2 = (unsigned)(sr2 * DQK + sc2) * 2u;
#define SLOAD(i, k0) do { const char* _vb = (const char*)Vh + (size_t)(k0) * (DV * 2); const char* _kb = (const char*)Kh + (size_t)(k0) * (DQK * 2); \
    sr_[i].vs = *(const bf16x8*)(_vb + voffg); sr_[i].ks = *(const bf16x8*)(_kb + koffg); \
    if (kx) sr_[i].ks2 = *(const bf16x8*)(_kb + koffg2); } while (0)
#define SWRITE(b, i) do { *(bf16x8*)(V_lds + (b) * SHM_V + vst) = sr_[i].vs; *(bf16x8*)(K_lds + (b) * SHM_K + kst) = sr_[i].ks; \
    if (kx) *(bf16x8*)(K_lds + (b) * SHM_K + kst2) = sr_[i].ks2; } while (0)
#define RESC(a) do { if (!FAST && __any((a) < 1.f)) { if (hi == 0) al_l[r32] = (a); asm volatile("s_waitcnt lgkmcnt(0)" ::: "memory"); \
    _Pragma("unroll") for (int d = 0; d < 2; ++d) _Pragma("unroll") for (int r = 0; r < 16; ++r) o[d][r] *= al_l[crow(r, hi)]; } } while (0)
  f32x16 pA0, pA1, pB0, pB1; float mnA, mnB, alA, alB; bf16x8 pa0, pa1, pa2, pa3; const int NT = seq / 64;
  constexpr int SE = 0, SO = 1;
  SLOAD(SE, 0); SWRITE(0, SE); __syncthreads();
  qkt(pA0, pA1, K_lds, qr, r32, hi); partialSM<FAST>(pA0, pA1, m_reg, mnA, alA);
  SLOAD(SO, 64); if (2 < NT) SLOAD(SE, 128);
  SWRITE(1, SO); __syncthreads();
  for (int j = 1; j + 1 < NT; j += 2) {
    SBAR(); qkt(pB0, pB1, K_lds + SHM_K, qr, r32, hi);
    finishSM<FAST>(pA0, pA1, alA, l_reg, pa0, pa1, pa2, pa3); SBAR();
    SLOAD(SO, (j + 2) * 64); SBAR();
    pv_d0(o, vb0, pa0, pa1, pa2, pa3); partialSM<FAST>(pB0, pB1, m_reg, mnB, alB);
    __syncthreads(); SWRITE(0, SE);
    RESC(alB); __syncthreads();
    SBAR(); qkt(pA0, pA1, K_lds, qr, r32, hi);
    finishSM<FAST>(pB0, pB1, alB, l_reg, pa0, pa1, pa2, pa3); SBAR();
    if (j + 3 < NT) SLOAD(SE, (j + 3) * 64); SBAR();
    pv_d0(o, vb0 + SHM_V, pa0, pa1, pa2, pa3); partialSM<FAST>(pA0, pA1, m_reg, mnA, alA);
    __syncthreads(); SWRITE(1, SO);
    RESC(alA); __syncthreads();
  }
  SBAR(); qkt(pB0, pB1, K_lds + SHM_K, qr, r32, hi);
  finishSM<FAST>(pA0, pA1, alA, l_reg, pa0, pa1, pa2, pa3); SBAR();
  pv_d0(o, vb0, pa0, pa1, pa2, pa3); partialSM<FAST>(pB0, pB1, m_reg, mnB, alB);
  __syncthreads(); RESC(alB);
  finishSM<FAST>(pB0, pB1, alB, l_reg, pa0, pa1, pa2, pa3); SBAR();
  pv_d0(o, vb0 + SHM_V, pa0, pa1, pa2, pa3);
  if constexpr (FAST) { auto rr = __builtin_amdgcn_permlane32_swap(__float_as_uint(l_reg), __float_as_uint(l_reg), false, false);
    l_reg = __uint_as_float(rr[0]) + __uint_as_float(rr[1]); }
  if (hi == 0) li_l[r32] = l_reg; asm volatile("s_waitcnt lgkmcnt(0)" ::: "memory");
#pragma unroll
  for (int r = 0; r < 16; ++r) {
    const int row = orow0 + wid * 32 + crow(r, hi);
    const float rli = __builtin_amdgcn_rcpf(li_l[crow(r, hi)]);
#pragma unroll
    for (int d0 = 0; d0 < 2; ++d0) {
      const int col = h * 64 + d0 * 32 + r32;
      const float g = bf2f((short)U[(size_t)row * DIN + U_GA + col]);
      Y[(size_t)row * DM + col] = f2bf(o[d0][r] * rli * silu_f(g));
    }
  }
  __syncthreads();
#undef SLOAD
#undef SWRITE
#undef RESC
}

template <int D0> DI void pv2_one(f32x16& oa, f32x16& ob, int vb, const bf16x8 (&pa)[4], const bf16x8 (&pb)[4]) {
  const s16x4 l0 = tr_read<v_rd_off(D0, 0, 0)>(vb), h0 = tr_read<v_rd_off(D0, 0, 1)>(vb), l1 = tr_read<v_rd_off(D0, 1, 0)>(vb), h1 = tr_read<v_rd_off(D0, 1, 1)>(vb);
  const s16x4 l2 = tr_read<v_rd_off(D0, 2, 0)>(vb), h2 = tr_read<v_rd_off(D0, 2, 1)>(vb), l3 = tr_read<v_rd_off(D0, 3, 0)>(vb), h3 = tr_read<v_rd_off(D0, 3, 1)>(vb);
#define PK(L, H) (bf16x8){L[0], L[1], L[2], L[3], H[0], H[1], H[2], H[3]}
  oa = __builtin_amdgcn_mfma_f32_32x32x16_bf16(pa[0], PK(l0, h0), oa, 0, 0, 0);
  ob = __builtin_amdgcn_mfma_f32_32x32x16_bf16(pb[0], PK(l0, h0), ob, 0, 0, 0);
  oa = __builtin_amdgcn_mfma_f32_32x32x16_bf16(pa[1], PK(l1, h1), oa, 0, 0, 0);
  ob = __builtin_amdgcn_mfma_f32_32x32x16_bf16(pb[1], PK(l1, h1), ob, 0, 0, 0);
  oa = __builtin_amdgcn_mfma_f32_32x32x16_bf16(pa[2], PK(l2, h2), oa, 0, 0, 0);
  ob = __builtin_amdgcn_mfma_f32_32x32x16_bf16(pb[2], PK(l2, h2), ob, 0, 0, 0);
  oa = __builtin_amdgcn_mfma_f32_32x32x16_bf16(pa[3], PK(l3, h3), oa, 0, 0, 0);
  ob = __builtin_amdgcn_mfma_f32_32x32x16_bf16(pb[3], PK(l3, h3), ob, 0, 0, 0);
#undef PK
}
DI void sm_accB(f32x16& p0, f32x16& p1, float& l_reg, bf16x8 (&pf)[4]) {
#pragma unroll
  for (int r = 0; r < 16; ++r) p0[r] = __builtin_amdgcn_exp2f(p0[r]);
#pragma unroll
  for (int r = 0; r < 16; ++r) p1[r] = __builtin_amdgcn_exp2f(p1[r]);
  const f32x16 s16 = p0 + p1;
  using f32x8 = __attribute__((ext_vector_type(8))) float;
  using f32x2 = __attribute__((ext_vector_type(2))) float;
  const f32x8 s8 = __builtin_shufflevector(s16, s16, 0, 1, 2, 3, 4, 5, 6, 7) + __builtin_shufflevector(s16, s16, 8, 9, 10, 11, 12, 13, 14, 15);
  const f32x4 s4 = __builtin_shufflevector(s8, s8, 0, 1, 2, 3) + __builtin_shufflevector(s8, s8, 4, 5, 6, 7);
  const f32x2 s2 = __builtin_shufflevector(s4, s4, 0, 1) + __builtin_shufflevector(s4, s4, 2, 3);
  l_reg += s2[0] + s2[1];
#define PKS(P, S, OUT) do { u32x4 w = {cvtpk(P[8 * S + 0], P[8 * S + 1]), cvtpk(P[8 * S + 2], P[8 * S + 3]), cvtpk(P[8 * S + 4], P[8 * S + 5]), cvtpk(P[8 * S + 6], P[8 * S + 7])}; \
    OUT = *reinterpret_cast<bf16x8*>(&w); } while (0)
  PKS(p0, 0, pf[0]); PKS(p0, 1, pf[1]); PKS(p1, 0, pf[2]); PKS(p1, 1, pf[3]);
#undef PKS
}
template <int D0> DI void pvT2_one(f32x16& oa, f32x16& ob, int vb, const bf16x8 (&pa)[4], const bf16x8 (&pb)[4]) {
  const s16x4 l0 = tr_read<v_rd_off(D0, 0, 0)>(vb), h0 = tr_read<v_rd_off(D0, 0, 1)>(vb), l1 = tr_read<v_rd_off(D0, 1, 0)>(vb), h1 = tr_read<v_rd_off(D0, 1, 1)>(vb);
  const s16x4 l2 = tr_read<v_rd_off(D0, 2, 0)>(vb), h2 = tr_read<v_rd_off(D0, 2, 1)>(vb), l3 = tr_read<v_rd_off(D0, 3, 0)>(vb), h3 = tr_read<v_rd_off(D0, 3, 1)>(vb);
#define PK(L, H) (bf16x8){L[0], L[1], L[2], L[3], H[0], H[1], H[2], H[3]}
  oa = __builtin_amdgcn_mfma_f32_32x32x16_bf16(PK(l0, h0), pa[0], oa, 0, 0, 0);
  ob = __builtin_amdgcn_mfma_f32_32x32x16_bf16(PK(l0, h0), pb[0], ob, 0, 0, 0);
  oa = __builtin_amdgcn_mfma_f32_32x32x16_bf16(PK(l1, h1), pa[1], oa, 0, 0, 0);
  ob = __builtin_amdgcn_mfma_f32_32x32x16_bf16(PK(l1, h1), pb[1], ob, 0, 0, 0);
  oa = __builtin_amdgcn_mfma_f32_32x32x16_bf16(PK(l2, h2), pa[2], oa, 0, 0, 0);
  ob = __builtin_amdgcn_mfma_f32_32x32x16_bf16(PK(l2, h2), pb[2], ob, 0, 0, 0);
  oa = __builtin_amdgcn_mfma_f32_32x32x16_bf16(PK(l3, h3), pa[3], oa, 0, 0, 0);
  ob = __builtin_amdgcn_mfma_f32_32x32x16_bf16(PK(l3, h3), pb[3], ob, 0, 0, 0);
#undef PK
}
DI void attn_body64(const bfraw* __restrict__ Qb, const bfraw* __restrict__ Kh, const bfraw* __restrict__ Vh, int seq, int nrows, char* lds,
                    const bfraw* __restrict__ U, bfraw* __restrict__ Y, int orow0, int h) {
  int tid_ = TIDX(); asm volatile("" : "+v"(tid_));
  const int tid = tid_, wid = __builtin_amdgcn_readfirstlane(tid >> 6), lane = tid & 63, r32 = lane & 31, hi = lane >> 5;
  char* V_lds = lds; char* K_lds = lds + 3 * SHM_V;
  float* li_l = (float*)(lds + 3 * SHM_V + 3 * SHM_K) + wid * 64;
  const bool active = wid * 64 < nrows;
  float lA = 0.f, lB = 0.f; f32x16 oA[2] = {}, oB[2] = {}; bf16x8 qA[6], qB[6];
  {
    const bfraw* Qw = Qb + (size_t)((active ? wid * 64 : 0) + r32) * DQK + hi * 8;
#pragma unroll
    for (int d0 = 0; d0 < 6; ++d0) { qA[d0] = *(const bf16x8*)(Qw + d0 * 16); qB[d0] = *(const bf16x8*)(Qw + 32 * DQK + d0 * 16); }
  }
  const int t8 = tid & 255, srow = t8 >> 2, sq = t8 & 3;
  const int vb0 = (int)(uintptr_t)V_lds + v_rd_base(lane);
  bf16x8 gv0, gv1, gk0, gk1, gk2;
  const unsigned vog = (unsigned)(srow * DV + sq * 16) * 2u, kog = (unsigned)(srow * DQK + sq * 24) * 2u;
  const int vs0 = v_st_acc(srow, sq * 16), vs1 = v_st_acc(srow, sq * 16 + 8);
  const int ks0 = KSWZ(srow, (sq * 24) * 2), ks1 = KSWZ(srow, (sq * 24 + 8) * 2), ks2 = KSWZ(srow, (sq * 24 + 16) * 2);
#define SLOAD(k0) do { const char* _vb = (const char*)Vh + (size_t)(k0) * (DV * 2) + vog; const char* _kb = (const char*)Kh + (size_t)(k0) * (DQK * 2) + kog; \
    gv0 = *(const bf16x8*)(_vb); gv1 = *(const bf16x8*)(_vb + 16); gk0 = *(const bf16x8*)(_kb); gk1 = *(const bf16x8*)(_kb + 16); gk2 = *(const bf16x8*)(_kb + 32); } while (0)
#define SWRITE(b) do { *(bf16x8*)(V_lds + (b) * SHM_V + vs0) = gv0; *(bf16x8*)(V_lds + (b) * SHM_V + vs1) = gv1; \
    *(bf16x8*)(K_lds + (b) * SHM_K + ks0) = gk0; *(bf16x8*)(K_lds + (b) * SHM_K + ks1) = gk1; *(bf16x8*)(K_lds + (b) * SHM_K + ks2) = gk2; } while (0)
  const int NT = seq / 64;
  f32x16 sA0 = {}, sA1 = {}, sB0 = {}, sB1 = {};
#define QK_TILE(slot) do { const char* Ks = K_lds + (slot) * SHM_K; sA0 = f32x16{}; sA1 = f32x16{}; sB0 = f32x16{}; sB1 = f32x16{}; \
    bf16x8 kf[2][2]; \
    _Pragma("unroll") for (int d0 = 0; d0 < 2; ++d0) { const int cb = (d0 * 16 + hi * 8) * 2; \
      kf[d0][0] = *reinterpret_cast<const bf16x8*>(Ks + KSWZ(r32, cb)); kf[d0][1] = *reinterpret_cast<const bf16x8*>(Ks + KSWZ(32 + r32, cb)); } \
    _Pragma("unroll") for (int d0 = 0; d0 < 6; ++d0) { const bf16x8 b0 = kf[d0 & 1][0], b1 = kf[d0 & 1][1]; \
      sA0 = __builtin_amdgcn_mfma_f32_32x32x16_bf16(b0, qA[d0], sA0, 0, 0, 0); \
      sA1 = __builtin_amdgcn_mfma_f32_32x32x16_bf16(b1, qA[d0], sA1, 0, 0, 0); \
      sB0 = __builtin_amdgcn_mfma_f32_32x32x16_bf16(b0, qB[d0], sB0, 0, 0, 0); \
      sB1 = __builtin_amdgcn_mfma_f32_32x32x16_bf16(b1, qB[d0], sB1, 0, 0, 0); \
      if (d0 + 2 < 6) { const int cb = ((d0 + 2) * 16 + hi * 8) * 2; \
        kf[d0 & 1][0] = *reinterpret_cast<const bf16x8*>(Ks + KSWZ(r32, cb)); kf[d0 & 1][1] = *reinterpret_cast<const bf16x8*>(Ks + KSWZ(32 + r32, cb)); } } } while (0)
#define SM_PV_TILE(slot) do { bf16x8 pa[4], pb[4]; sm_accB(sA0, sA1, lA, pa); sm_accB(sB0, sB1, lB, pb); \
    const int vb = vb0 + (slot) * SHM_V; \
    pvT2_one<0>(oA[0], oB[0], vb, pa, pb); pvT2_one<1>(oA[1], oB[1], vb, pa, pb); } while (0)
  if (wid >= 4) {
    __syncthreads();
    int bt = 0;
    for (int t = 0; t < NT; ++t) {
      const int bn = (bt == 2) ? 0 : bt + 1, bp = (bt == 0) ? 2 : bt - 1;
      if (active) { if (t > 0) SM_PV_TILE(bp); QK_TILE(bt); }
      __syncthreads();
      bt = bn;
    }
    if (active) { const int bl = (bt == 0) ? 2 : bt - 1; SM_PV_TILE(bl); }
  } else {
    SLOAD(0); SWRITE(0); SLOAD(64);
    __syncthreads();
    int bt = 0;
    for (int t = 0; t < NT; ++t) {
      const int bn = (bt == 2) ? 0 : bt + 1;
      QK_TILE(bt);
      if (t + 1 < NT) { SWRITE(bn); if (t + 2 < NT) SLOAD((t + 2) * 64); }
      SM_PV_TILE(bt);
      __syncthreads();
      bt = bn;
    }
  }
#undef QK_TILE
#undef SM_PV_TILE
  if (active) {
    { auto rr = __builtin_amdgcn_permlane32_swap(__float_as_uint(lA), __float_as_uint(lA), false, false); lA = __uint_as_float(rr[0]) + __uint_as_float(rr[1]); }
    { auto rr = __builtin_amdgcn_permlane32_swap(__float_as_uint(lB), __float_as_uint(lB), false, false); lB = __uint_as_float(rr[0]) + __uint_as_float(rr[1]); }
#pragma unroll
    for (int g = 0; g < 2; ++g) {
      const int row = orow0 + wid * 64 + g * 32 + r32;
      const float rli = __builtin_amdgcn_rcpf(g == 0 ? lA : lB);
      const bfraw* up = U + (size_t)row * DIN + U_GA + h * 64 + 4 * hi;
      bfraw* yp = Y + (size_t)row * DM + h * 64 + 4 * hi;
#pragma unroll
      for (int d0 = 0; d0 < 2; ++d0)
#pragma unroll
        for (int q4 = 0; q4 < 4; ++q4) {
          const s16x4 gg = *(const s16x4*)(up + d0 * 32 + q4 * 8);
          float v[4];
#pragma unroll
          for (int j = 0; j < 4; ++j) { const float ov = (g == 0) ? oA[d0][q4 * 4 + j] : oB[d0][q4 * 4 + j]; v[j] = ov * rli * silu_f(bf2f(gg[j])); }
          *(u32x2*)(yp + d0 * 32 + q4 * 8) = pack4(v[0], v[1], v[2], v[3]);
        }
    }
  }
  __syncthreads();
#undef SLOAD
#undef SWRITE
}

DI void pd_attn(const Params& p, int l, char* lds) {
  const bfraw* Q = (const bfraw*)(p.ws + WS_Q); const bfraw* Kd = (const bfraw*)(p.ws + WS_K); const bfraw* Vd = (const bfraw*)(p.ws + WS_V);
  const bfraw* U = (const bfraw*)(p.ws + WS_U); bfraw* Y = (bfraw*)(p.ws + WS_H);
  const int nitem = 1024 + ((l == DEPTH - 1) ? 0 : 32);
  float mq = 0.f, mk = 0.f;
  for (int i = 0; i < DQK; ++i) { mq = fmaxf(mq, fabsf(p.q_head_norm_w[l * DQK + i])); mk = fmaxf(mk, fabsf(p.k_head_norm_w[l * DQK + i])); }
  const bool fast = (float)DQK * QSCALE * mq * mk * 1.05f < 60.f;
  if (fast) {
    const int nitem = 512 + ((l == DEPTH - 1) ? 0 : 32);
    for (int it = blockIdx.x; it < nitem; it += gridDim.x) {
      int b, h, q0, seq, orow0, nrows;
      if (it < 512) { b = it >> 7; h = it & 7; const int qb = (it >> 3) & 15; q0 = CLEN + qb * 512; seq = NKEY; orow0 = b * TSEQ + qb * 512; nrows = 512; }
      else { const int c = it - 512; b = c >> 3; h = c & 7; q0 = 0; seq = CLEN; orow0 = NLAT + b * CLEN; nrows = 256; }
      const size_t bh = (size_t)(b * NH + h) * NKEY;
      attn_body64(Q + (bh + q0) * DQK, Kd + bh * DQK, Vd + bh * DV, seq, nrows, lds, U, Y, orow0, h);
    }
  } else {
    for (int it = blockIdx.x; it < nitem; it += gridDim.x) {
      int b, h, q0, seq, orow0;
      if (it < 1024) { b = it >> 8; h = it & 7; const int qb = (it >> 3) & 31; q0 = CLEN + qb * 256; seq = NKEY; orow0 = b * TSEQ + qb * 256; }
      else { const int c = it - 1024; b = c >> 3; h = c & 7; q0 = 0; seq = CLEN; orow0 = NLAT + b * CLEN; }
      const size_t bh = (size_t)(b * NH + h) * NKEY;
      attn_body<false>(Q + (bh + q0) * DQK, Kd + bh * DQK, Vd + bh * DV, seq, lds, U, Y, orow0, h);
    }
  }
}

#define XB_TMO      128
#define XB_XCNT(j)  (256  + 64 * (j))
#define XB_XSUB(j)  (1280 + 64 * (j))
#define XB_XGEN(j)  (2304 + 64 * (j))
#define XB_TOP      3328
#define XB_TOPGEN   3392
#define XCD_BAR_WORDS 3456
#define XB_SPIN_CAP (1u << 18)
#define LAS __attribute__((address_space(3)))

__device__ __forceinline__ unsigned xb_ld(unsigned* p)              { return __hip_atomic_load(p, __ATOMIC_RELAXED, __HIP_MEMORY_SCOPE_AGENT); }
__device__ __forceinline__ unsigned xb_add(unsigned* p, unsigned v) { return __hip_atomic_fetch_add(p, v, __ATOMIC_RELAXED, __HIP_MEMORY_SCOPE_AGENT); }
__device__ __forceinline__ unsigned xb_xcc_id() { return (unsigned)__builtin_amdgcn_s_getreg((3 << 11) | 20) & 0xFu; }
#define XB_SPIN(cond, bar) do { unsigned _sp = 0; while (cond) { __builtin_amdgcn_s_sleep(1); \
    if ((++_sp & 255u) == 0u) { if (xb_ld(&(bar)[XB_TMO])) break; if (_sp > XB_SPIN_CAP) { atomicAdd(&(bar)[XB_TMO], 1u); break; } } } } while (0)

struct XcdBarrier {
    unsigned* bar; unsigned x;
    volatile LAS unsigned* st;
};

__device__ __forceinline__ XcdBarrier xcd_barrier_post(unsigned* bar, volatile LAS unsigned* st) {
    XcdBarrier b; b.bar = bar; b.x = xb_xcc_id(); b.st = st;
    if (TIDX() == 0) (void)xb_add(&bar[XB_XCNT(b.x)], 1u);
    return b;
}
__device__ __forceinline__ void xcd_barrier_complete(unsigned* bar, unsigned x, unsigned& nloc, unsigned& nx) {
    const unsigned G = gridDim.x * gridDim.y * gridDim.z;
    unsigned sum, cnt, mine, sp = 0u;
    for (;;) {
        sum = 0u; cnt = 0u; mine = 0u;
#pragma unroll
        for (unsigned j = 0; j < 16; ++j) { const unsigned c = xb_ld(&bar[XB_XCNT(j)]); sum += c; cnt += (c > 0u) ? 1u : 0u; mine = (j == x) ? c : mine; }
        if (sum == G) break;
        __builtin_amdgcn_s_sleep(1);
        if ((++sp & 255u) == 0u) { if (xb_ld(&bar[XB_TMO])) break; if (sp > XB_SPIN_CAP) { atomicAdd(&bar[XB_TMO], 1u); break; } }
    }
    nloc = mine > 0u ? mine : 1u; nx = cnt > 0u ? cnt : 1u;
}

__device__ __forceinline__ void xcd_barrier(const XcdBarrier& b) {
    asm volatile("s_waitcnt vmcnt(0)" ::: "memory");
    __syncthreads();
    if (TIDX() == 0) {
        unsigned* bar = b.bar;
        __builtin_amdgcn_s_waitcnt(0);
        unsigned nloc = b.st[0], nx = b.st[1];
        if (nloc == 0u) { xcd_barrier_complete(bar, b.x, nloc, nx); b.st[0] = nloc; b.st[1] = nx; }
        const unsigned old = xb_add(&bar[XB_XSUB(b.x)], 1u);
        const unsigned gen = old / nloc;
        if (old + 1u == (gen + 1u) * nloc) {
            __builtin_amdgcn_fence(__ATOMIC_RELEASE, "agent");
            asm volatile("s_waitcnt vmcnt(0)" ::: "memory");
            const unsigned og = xb_add(&bar[XB_TOP], 1u);
            const unsigned tg = og / nx;
            if (og + 1u == (tg + 1u) * nx) xb_add(&bar[XB_TOPGEN], 1u);
            else XB_SPIN(xb_ld(&bar[XB_TOPGEN]) == tg, bar);
            __builtin_amdgcn_fence(__ATOMIC_ACQUIRE, "agent");
            xb_add(&bar[XB_XGEN(b.x)], 1u);
            asm volatile("s_waitcnt vmcnt(0)" ::: "memory");
        } else {
            XB_SPIN(xb_ld(&bar[XB_XGEN(b.x)]) == gen, bar);
            __builtin_amdgcn_fence(__ATOMIC_ACQUIRE, "agent");
            asm volatile("s_waitcnt vmcnt(0)" ::: "memory");
        }
    }
    __syncthreads();
}

__global__ void __launch_bounds__(NTHR) mega(Params p) {
  extern __shared__ __attribute__((aligned(16))) char lds[];
  const int lo = p.ph_lo, hi = p.ph_hi;
  const bool fused = (lo == 0 && hi == 1 + 5 * DEPTH);
  volatile LAS unsigned* st = (volatile LAS unsigned*)(lds + LDS_PHASE_BYTES);
  if (TIDX() == 0) { st[0] = 0u; st[1] = 0u; }
  __syncthreads();
#define SEAM() do { XcdBarrier b_; b_.bar = (unsigned*)(p.ws + WS_BAR); b_.x = xb_xcc_id(); b_.st = (volatile LAS unsigned*)(lds + LDS_PHASE_BYTES); xcd_barrier(b_); } while (0)
#define PHASE(k, call) if (lo <= (k) && (k) < hi) { if (fused && (k) > 1) SEAM(); call; }
  if (lo == 0) {
    p0_prologue(p, lds);
    if (fused) {
      unsigned* barw = (unsigned*)(p.ws + WS_BAR);
      if (blockIdx.x == 0) for (int i = TIDX(); i < XCD_BAR_WORDS; i += NTHR) barw[i] = 0u;
      cg::this_grid().sync();
      (void)xcd_barrier_post(barw, st);
    }
  }
  PHASE(1, pa_norm(p, 0))
  PHASE(2, pb_inproj(p, 0, lds))
  PHASE(3, (pc_q(p, 0, lds), pc_kv(p, 0, lds), pc_conv(p, 0, lds)))
  PHASE(4, pd_attn(p, 0, lds))
  PHASE(5, pe_outproj(p, 0, lds))
  PHASE(6, pa_norm(p, 1))
  PHASE(7, pb_inproj(p, 1, lds))
  PHASE(8, (pc_q(p, 1, lds), pc_kv(p, 1, lds), pc_conv(p, 1, lds)))
  PHASE(9, pd_attn(p, 1, lds))
  PHASE(10, pe_outproj(p, 1, lds))
#undef PHASE
#undef SEAM
}

extern "C" void kernel_launch(void* const* d_in, const int* in_sizes, int n_in, void* d_out, int out_size, void* d_ws, size_t ws_size,
                              hipStream_t stream) {
  static int grid_blocks = 0;
  if (grid_blocks == 0) {
    if (n_in != 22 || out_size != NLAT * DM || ws_size < WS_END) {
      fprintf(stderr, "kernel_launch: unexpected shapes n_in %d out %d ws %zu (need %zu)\n", n_in, out_size, ws_size, (size_t)WS_END); grid_blocks = -1; return; }
    int dev = 0, cus = 0, per_cu = 0;
    hipGetDevice(&dev);
    hipDeviceGetAttribute(&cus, hipDeviceAttributeMultiprocessorCount, dev);
    if (hipFuncSetAttribute((const void*)mega, hipFuncAttributeMaxDynamicSharedMemorySize, LDS_BYTES) != hipSuccess) {
      fprintf(stderr, "kernel_launch: hipFuncSetAttribute failed\n"); grid_blocks = -1; return; }
    hipOccupancyMaxActiveBlocksPerMultiprocessor(&per_cu, (const void*)mega, NTHR, LDS_BYTES);
    if (per_cu < 1) per_cu = 1;
    grid_blocks = cus * per_cu;
    (void)hipGetLastError();
  }
  if (grid_blocks < 0) return;
  Params p{};
  const float** pp = (const float**)&p;
  for (int i = 0; i < 22; ++i) pp[i] = (const float*)d_in[i];
  p.out = (float*)d_out; p.ws = (unsigned char*)d_ws;
  constexpr int NPH = 1 + 5 * DEPTH;
#if ONE_LAUNCH
  p.ph_lo = 0; p.ph_hi = NPH;
  void* args[] = {&p};
  hipError_t e = hipLaunchCooperativeKernel((const void*)mega, dim3(grid_blocks), dim3(NTHR), args, LDS_BYTES, stream);
  if (e != hipSuccess) fprintf(stderr, "cooperative launch failed: %s (grid %d)\n", hipGetErrorString(e), grid_blocks);
#else
  for (int ph = 0; ph < NPH; ++ph) {
    p.ph_lo = ph; p.ph_hi = ph + 1;
    hipLaunchKernelGGL(mega, dim3(grid_blocks), dim3(NTHR), LDS_BYTES, stream, p);
  }
#endif
}
```
